# Optimizing an MI355X kernel written in HIP

```python
import math
import jax, jax.numpy as jnp
from jax import lax
import numpy as np

D_MODEL = 1024
BATCH = 4
SEQ = 4096
DEPTH = 4

GRID_W = 64
CTX_LEN = 256
N_MIXERS = 3
N_LAYERS_A = (DEPTH + 2) // 3
N_LAYERS_B = (DEPTH + 1) // 3
N_LAYERS_C = DEPTH // 3

A_HEADS = 8
A_KV_HEADS = 2
A_HEAD_DIM = 128
B_HEADS = 16
B_HEAD_DIM = D_MODEL // B_HEADS
B_MAX_KH = 8
B_KW = 16
C_HEADS = 8
C_NOPE = 128
C_ROPE = 64
C_V = 128
C_Q_RANK = 384
C_KV_RANK = 256
D_FF = -(-8 * D_MODEL // (3 * 256)) * 256

ROPE_BASE = 10000.0
Q_BLOCK = 128
RMS_EPS = 1e-6
LN_EPS = 1e-5
DEEPNORM_ALPHA = (2.0 * DEPTH) ** 0.25
DEEPNORM_BETA = (8.0 * DEPTH) ** -0.25

kernel_name = "hybrid_interleaved_gqa_natten_mla_deepnorm"


def rms_norm(t, g):
    tf = t.astype(jnp.float32)
    y = tf * lax.rsqrt(jnp.mean(tf * tf, axis=-1, keepdims=True) + RMS_EPS)
    return (y * g.astype(jnp.float32)).astype(t.dtype)


def layer_norm(t, g, b):
    tf = t.astype(jnp.float32)
    mu = jnp.mean(tf, axis=-1, keepdims=True)
    var = jnp.mean(jnp.square(tf - mu), axis=-1, keepdims=True)
    y = (tf - mu) * lax.rsqrt(var + LN_EPS)
    return (y * g.astype(jnp.float32) + b.astype(jnp.float32)).astype(t.dtype)


def modulate(t, shift, scale):
    return t * (1 + scale) + shift


def rope_1d(t, ang):
    cos = jnp.cos(ang)[None, :, None, :].astype(t.dtype)
    sin = jnp.sin(ang)[None, :, None, :].astype(t.dtype)
    t1, t2 = jnp.split(t, 2, axis=-1)
    return jnp.concatenate([t1 * cos - t2 * sin, t2 * cos + t1 * sin], axis=-1)


def axial_rope(t, pos_r, pos_c):
    half = t.shape[-1] // 2
    freqs = ROPE_BASE ** (-jnp.arange(0, half, 2, dtype=jnp.float32) / half)
    ang_r = pos_r.astype(jnp.float32)[:, None] * freqs[None, :]
    ang_c = pos_c.astype(jnp.float32)[:, None] * freqs[None, :]
    t_r, t_c = jnp.split(t, 2, axis=-1)
    return jnp.concatenate([rope_1d(t_r, ang_r), rope_1d(t_c, ang_c)], axis=-1)


def softmax_attend(q, keys, vals, scale):
    s = jnp.concatenate([jnp.einsum('bqgrd,bkgd->bgrqk', q, k) for k in keys], axis=-1)
    p = jax.nn.softmax(s.astype(jnp.float32) * scale, axis=-1).astype(q.dtype)
    offs = np.cumsum([0] + [k.shape[1] for k in keys])
    out = None
    for j, vj in enumerate(vals):
        pj = p[..., int(offs[j]):int(offs[j + 1])]
        oj = jnp.einsum('bgrqk,bkgd->bqgrd', pj, vj)
        out = oj if out is None else out + oj
    return out


def blocked_attention(q, k, v, kc, vc, scale):
    B, N, G, R, dk = q.shape
    nb = N // Q_BLOCK
    qb = q.reshape(B, nb, Q_BLOCK, G, R, dk).transpose(1, 0, 2, 3, 4, 5)
    ob = lax.map(lambda qi: softmax_attend(qi, [k, kc], [v, vc], scale), qb)
    return ob.transpose(1, 0, 2, 3, 4, 5).reshape(B, N, G, R, v.shape[-1])


def swiglu(t, w_gate, w_up, w_down):
    return (jax.nn.silu(t @ w_gate) * (t @ w_up)) @ w_down


def mixer_gqa(h, hc, w_qkv, q_gain, k_gain, w_o, pos_r, pos_c, need_ctx):
    B, N, _ = h.shape
    L = hc.shape[1]
    rep = A_HEADS // A_KV_HEADS
    split = [A_HEADS * A_HEAD_DIM, (A_HEADS + A_KV_HEADS) * A_HEAD_DIM]

    def proj(t):
        bt, tt, _ = t.shape
        q, k, v = jnp.split(t @ w_qkv, split, axis=-1)
        q = rms_norm(q.reshape(bt, tt, A_HEADS, A_HEAD_DIM), q_gain)
        k = rms_norm(k.reshape(bt, tt, A_KV_HEADS, A_HEAD_DIM), k_gain)
        v = v.reshape(bt, tt, A_KV_HEADS, A_HEAD_DIM)
        return q, k, v

    q, k, v = proj(h)
    qc, kc, vc = proj(hc)
    q = axial_rope(q, pos_r, pos_c)
    k = axial_rope(k, pos_r, pos_c)
    scale = A_HEAD_DIM ** -0.5
    o = blocked_attention(q.reshape(B, N, A_KV_HEADS, rep, A_HEAD_DIM), k, v, kc, vc, scale)
    y = o.reshape(B, N, A_HEADS * A_HEAD_DIM) @ w_o
    yc = None
    if need_ctx:
        oc = softmax_attend(qc.reshape(B, L, A_KV_HEADS, rep, A_HEAD_DIM), [kc], [vc], scale)
        yc = oc.reshape(B, L, A_HEADS * A_HEAD_DIM) @ w_o
    return y, yc


def mixer_neighbourhood(h, hc, w_qkv, rpb, w_o, need_ctx):
    B, N, _ = h.shape
    L = hc.shape[1]
    rows = N // GRID_W
    kh = min(B_MAX_KH, rows)
    scale = B_HEAD_DIM ** -0.5

    def proj(t):
        bt, tt, _ = t.shape
        q, k, v = jnp.split(t @ w_qkv, 3, axis=-1)
        shp = (bt, tt, B_HEADS, B_HEAD_DIM)
        return q.reshape(shp), k.reshape(shp), v.reshape(shp)

    q, k, v = proj(h)
    qc, kc, vc = proj(hc)
    grid = (B, rows, GRID_W, B_HEADS, B_HEAD_DIM)
    k = k.reshape(grid)
    v = v.reshape(grid)
    q_rows = q.reshape(grid).transpose(1, 0, 2, 3, 4)

    col = jnp.arange(GRID_W)
    col_start = jnp.clip(col - B_KW // 2, 0, GRID_W - B_KW)
    col_idx = col_start[:, None] + jnp.arange(B_KW)[None, :]
    dc = col_idx - col[:, None] + (B_KW - 1)
    bias_c = rpb[:, :, dc]

    def row_block(args):
        r, qr = args
        rs = jnp.clip(r - kh // 2, 0, rows - kh)
        k_rows = lax.dynamic_slice_in_dim(k, rs, kh, axis=1)
        v_rows = lax.dynamic_slice_in_dim(v, rs, kh, axis=1)
        k_win = k_rows[:, :, col_idx]
        v_win = v_rows[:, :, col_idx]
        dr = rs + jnp.arange(kh) - r + (B_MAX_KH - 1)
        bias = jnp.take(bias_c, dr, axis=1).transpose(0, 2, 1, 3)
        s_loc = (jnp.einsum('bwhd,biwjhd->bhwij', qr, k_win).astype(jnp.float32) * scale
                 + bias[None].astype(jnp.float32)).reshape(B, B_HEADS, GRID_W, kh * B_KW)
        s_ctx = jnp.einsum('bwhd,blhd->bhwl', qr, kc).astype(jnp.float32) * scale
        p = jax.nn.softmax(jnp.concatenate([s_loc, s_ctx], axis=-1), axis=-1).astype(qr.dtype)
        p_loc = p[..., :kh * B_KW].reshape(B, B_HEADS, GRID_W, kh, B_KW)
        p_ctx = p[..., kh * B_KW:]
        return (jnp.einsum('bhwij,biwjhd->bwhd', p_loc, v_win)
                + jnp.einsum('bhwl,blhd->bwhd', p_ctx, vc))

    o_rows = lax.map(row_block, (jnp.arange(rows), q_rows))
    y = o_rows.transpose(1, 0, 2, 3, 4).reshape(B, N, D_MODEL) @ w_o
    yc = None
    if need_ctx:
        oc = softmax_attend(qc[:, :, :, None, :], [kc], [vc], scale)
        yc = oc.reshape(B, L, D_MODEL) @ w_o
    return y, yc


def mixer_mla(h, hc, w_dqkv, q_a_gain, kv_a_gain, w_uq, w_ukv, w_o, pos_r, pos_c, need_ctx):
    B, N, _ = h.shape
    L = hc.shape[1]
    scale = (C_NOPE + C_ROPE) ** -0.5

    def proj(t, rotate):
        bt, tt, _ = t.shape
        q_lat, kv_lat, k_rope = jnp.split(t @ w_dqkv, [C_Q_RANK, C_Q_RANK + C_KV_RANK], axis=-1)
        q = (rms_norm(q_lat, q_a_gain) @ w_uq).reshape(bt, tt, C_HEADS, C_NOPE + C_ROPE)
        kv = (rms_norm(kv_lat, kv_a_gain) @ w_ukv).reshape(bt, tt, C_HEADS, C_NOPE + C_V)
        q_nope, q_rope = jnp.split(q, [C_NOPE], axis=-1)
        k_nope, v = jnp.split(kv, [C_NOPE], axis=-1)
        k_rope = k_rope[:, :, None, :]
        if rotate:
            q_rope = axial_rope(q_rope, pos_r, pos_c)
            k_rope = axial_rope(k_rope, pos_r, pos_c)
        q = jnp.concatenate([q_nope, q_rope], axis=-1)
        k = jnp.concatenate([k_nope, jnp.broadcast_to(k_rope, (bt, tt, C_HEADS, C_ROPE))], axis=-1)
        return q[:, :, :, None, :], k, v

    q, k, v = proj(h, True)
    qc, kc, vc = proj(hc, False)
    o = blocked_attention(q, k, v, kc, vc, scale)
    y = o.reshape(B, N, C_HEADS * C_V) @ w_o
    yc = None
    if need_ctx:
        oc = softmax_attend(qc, [kc], [vc], scale)
        yc = oc.reshape(B, L, C_HEADS * C_V) @ w_o
    return y, yc


def setup_inputs(seed: int = 0) -> dict:
    key = jax.random.key(seed)
    ks = iter(jax.random.split(key, 32))

    def nrm(shape, scale):
        return jax.random.normal(next(ks), shape, jnp.float32) * scale

    def gain(shape):
        return 1.0 + nrm(shape, 0.02)

    D = D_MODEL
    inp = {}
    inp["x"] = nrm((BATCH, SEQ, D), 1.0)
    inp["c"] = nrm((BATCH, D), 1.0)
    inp["ctx"] = nrm((BATCH, CTX_LEN, D), 1.0)
    inp["c_ctx"] = nrm((D,), 1.0)
    inp["w_ada"] = nrm((DEPTH, D, 6 * D), 0.5 * D ** -0.5)
    inp["b_ada"] = nrm((DEPTH, 6 * D), 0.02)
    inp["ln_g"] = gain((DEPTH, 2, D))
    inp["ln_b"] = nrm((DEPTH, 2, D), 0.02)
    inp["w_ffn_gate"] = nrm((DEPTH, D, D_FF), D ** -0.5)
    inp["w_ffn_up"] = nrm((DEPTH, D, D_FF), D ** -0.5)
    inp["w_ffn_down"] = nrm((DEPTH, D_FF, D), DEEPNORM_BETA * D_FF ** -0.5)
    inp["a_w_qkv"] = nrm((N_LAYERS_A, D, (A_HEADS + 2 * A_KV_HEADS) * A_HEAD_DIM), D ** -0.5)
    inp["a_q_gain"] = gain((N_LAYERS_A, A_HEAD_DIM))
    inp["a_k_gain"] = gain((N_LAYERS_A, A_HEAD_DIM))
    inp["a_w_o"] = nrm((N_LAYERS_A, A_HEADS * A_HEAD_DIM, D), DEEPNORM_BETA * (A_HEADS * A_HEAD_DIM) ** -0.5)
    inp["b_w_qkv"] = nrm((N_LAYERS_B, D, 3 * D), D ** -0.5)
    inp["b_rpb"] = nrm((N_LAYERS_B, B_HEADS, 2 * B_MAX_KH - 1, 2 * B_KW - 1), 0.5)
    inp["b_w_o"] = nrm((N_LAYERS_B, D, D), DEEPNORM_BETA * D ** -0.5)
    inp["c_w_dqkv"] = nrm((N_LAYERS_C, D, C_Q_RANK + C_KV_RANK + C_ROPE), D ** -0.5)
    inp["c_q_a_gain"] = gain((N_LAYERS_C, C_Q_RANK))
    inp["c_kv_a_gain"] = gain((N_LAYERS_C, C_KV_RANK))
    inp["c_w_uq"] = nrm((N_LAYERS_C, C_Q_RANK, C_HEADS * (C_NOPE + C_ROPE)), C_Q_RANK ** -0.5)
    inp["c_w_ukv"] = nrm((N_LAYERS_C, C_KV_RANK, C_HEADS * (C_NOPE + C_V)), C_KV_RANK ** -0.5)
    inp["c_w_o"] = nrm((N_LAYERS_C, C_HEADS * C_V, D), DEEPNORM_BETA * (C_HEADS * C_V) ** -0.5)
    return inp


def reference(x, c, ctx, c_ctx, w_ada, b_ada, ln_g, ln_b, w_ffn_gate, w_ffn_up, w_ffn_down,
              a_w_qkv, a_q_gain, a_k_gain, a_w_o,
              b_w_qkv, b_rpb, b_w_o,
              c_w_dqkv, c_q_a_gain, c_kv_a_gain, c_w_uq, c_w_ukv, c_w_o):
    N = x.shape[1]
    t = jnp.arange(N)
    pos_r = t // GRID_W
    pos_c = t % GRID_W
    cond_lat = jax.nn.silu(c)
    cond_ctx = jax.nn.silu(c_ctx)
    xc = ctx
    for i in range(DEPTH):
        need_ctx = i < DEPTH - 1
        mod = cond_lat @ w_ada[i] + b_ada[i]
        mod_c = cond_ctx @ w_ada[i] + b_ada[i]
        sh1, sc1, g1, sh2, sc2, g2 = jnp.split(mod[:, None, :], 6, axis=-1)
        sh1c, sc1c, g1c, sh2c, sc2c, g2c = jnp.split(mod_c, 6, axis=-1)
        h = modulate(x, sh1, sc1)
        hc = modulate(xc, sh1c, sc1c)
        kind, j = i % N_MIXERS, i // N_MIXERS
        if kind == 0:
            y, yc = mixer_gqa(h, hc, a_w_qkv[j], a_q_gain[j], a_k_gain[j], a_w_o[j],
                              pos_r, pos_c, need_ctx)
        elif kind == 1:
            y, yc = mixer_neighbourhood(h, hc, b_w_qkv[j], b_rpb[j], b_w_o[j], need_ctx)
        else:
            y, yc = mixer_mla(h, hc, c_w_dqkv[j], c_q_a_gain[j], c_kv_a_gain[j], c_w_uq[j],
                              c_w_ukv[j], c_w_o[j], pos_r, pos_c, need_ctx)
        x = layer_norm(DEEPNORM_ALPHA * x + g1 * y, ln_g[i, 0], ln_b[i, 0])
        f = swiglu(modulate(x, sh2, sc2), w_ffn_gate[i], w_ffn_up[i], w_ffn_down[i])
        x = layer_norm(DEEPNORM_ALPHA * x + g2 * f, ln_g[i, 1], ln_b[i, 1])
        if need_ctx:
            xc = layer_norm(DEEPNORM_ALPHA * xc + g1c * yc, ln_g[i, 0], ln_b[i, 0])
            fc = swiglu(modulate(xc, sh2c, sc2c), w_ffn_gate[i], w_ffn_up[i], w_ffn_down[i])
            xc = layer_norm(DEEPNORM_ALPHA * xc + g2c * fc, ln_g[i, 1], ln_b[i, 1])
    return x
```

```cpp
#include <hip/hip_runtime.h>
#include <hip/hip_cooperative_groups.h>
#include <cstdio>
#include <cstdint>
namespace cg = cooperative_groups;
__device__ __forceinline__ int tidx() { int t = threadIdx.x; asm volatile("" : "+v"(t)); return t; }
__device__ __forceinline__ int bidx() { int b = blockIdx.x; asm volatile("" : "+s"(b)); return b; }
namespace pg8 {
#define PG8_LAS __attribute__((address_space(3)))
typedef unsigned short bf16_t;
typedef short bf16x8 __attribute__((ext_vector_type(8)));
typedef float f32x4 __attribute__((ext_vector_type(4)));
typedef unsigned u32x4 __attribute__((ext_vector_type(4)));
constexpr int BM = 256, BK = 64, HALF = 128, HTB = HALF * BK * 2  , STAGE_BYTES = 8 * HTB, NXCD = 8, WGM = 8;

__host__ __device__ __forceinline__ int lds_byte(int r, int c) { const int st = (r >> 4) * 2 + (c >> 5), rr = r & 15, cc = c & 31, ob = rr * 64 + cc * 2; return st * 1024 + (ob ^ (((ob >> 9) & 1) << 5)); }
__host__ __device__ __forceinline__ void stage_rc(int b, int& R, int& C) { const int st = b / 1024, sb = b % 1024, swz = sb ^ (((sb >> 9) & 1) << 5); R = (st >> 1) * 16 + swz / 64; C = (st & 1) * 32 + (swz % 64) / 2; }
__host__ __device__ __forceinline__ int perm32(int rho) { const int n = rho >> 4, i = rho & 15; return 8 * (i >> 2) + 4 * n + (i & 3); }

struct Unit { int pm, pn; };
struct Gemm { const bf16_t* A; const bf16_t* Bt; int M, N, K; };

struct StaticOrder {
    int nM, nN, nwg, G, c;
    __host__ __device__ void init(int M, int N, int G_, int c_) { nM = M / BM; nN = N / BM; nwg = nM * nN; G = G_; c = c_; }
    __host__ __device__ bool next(int i, Unit& u) const {
        const long L = (long)i * G + c; if (L >= nwg) return false;
        int wgid = (int)L; { const int q = nwg / NXCD, r = nwg % NXCD, xcd = wgid % NXCD, off = wgid / NXCD; wgid = (xcd < r ? xcd * (q + 1) : r * (q + 1) + (xcd - r) * q) + off; }
        const int nig = WGM * nN, gid = wgid / nig, fm = gid * WGM, gsz = (nM - fm) < WGM ? (nM - fm) : WGM;
        u.pm = fm + ((wgid % nig) % gsz); u.pn = (wgid % nig) / gsz; return true;
    }
    __device__ __forceinline__ void a_ready(const Unit&) const {}
    __device__ __forceinline__ void done(const Unit&) const {}
};
template <class Epi, class Sched, bool ALIGN_EPI = false, bool SP2 = false>
__device__ __forceinline__ void gemm_phase(PG8_LAS unsigned char* lds, const Gemm g, const Sched& S, const Epi& E) {
    const int tid = tidx(), wid = __builtin_amdgcn_readfirstlane(tid >> 6), lane = tid & 63, wr = wid >> 2, wc = wid & 3, fr = lane & 15, fq = lane >> 4;
    const int K = g.K, nt = K / BK;
    unsigned voffA[2], voffB[2];
#pragma unroll
    for (int i = 0; i < 2; ++i) { int R, C; stage_rc(tid * 16 + i * 8192, R, C); const int Rb = Epi::PERM ? ((R & ~31) + perm32(R & 31)) : R;
        voffA[i] = (unsigned)(R * K + C) * 2u; voffB[i] = (unsigned)(Rb * K + C) * 2u; }
    const size_t kstep = (size_t)(BK * 2);
    const size_t hstep = (size_t)HALF * K * 2;
    const size_t tstep = 2 * hstep;
    const unsigned ldsw = (unsigned)wid * 1024u;
    const int aoff = lds_byte(wr * 64 + fr, fq * 8), boff = lds_byte(wc * 32 + fr, fq * 8);
#define PG8_SA(b, h) (((b) * 2 + (h)) * HTB)
#define PG8_SB(b, h) ((4 + (b) * 2 + (h)) * HTB)
#define PG8_STAGE(bufoff, gbase, voff) do { _Pragma("unroll") for (int _i = 0; _i < 2; ++_i) \
        __builtin_amdgcn_global_load_lds((const unsigned*)((const char*)(gbase) + (voff)[_i]), (PG8_LAS unsigned*)(lds + (bufoff) + ldsw + _i * 8192), 16, 0, 0); } while (0)
#define PG8_LDA(dst, b, h) do { _Pragma("unroll") for (int m = 0; m < 4; ++m) _Pragma("unroll") for (int k = 0; k < 2; ++k) dst[m][k] = *(const PG8_LAS bf16x8*)(lds + PG8_SA(b, h) + aoff + m * 2048 + k * 1024); } while (0)
#define PG8_LDB(dst, b, h) do { _Pragma("unroll") for (int n = 0; n < 2; ++n) _Pragma("unroll") for (int k = 0; k < 2; ++k) dst[n][k] = *(const PG8_LAS bf16x8*)(lds + PG8_SB(b, h) + boff + n * 2048 + k * 1024); } while (0)
#define PG8_MMA(ai, bj, At, Bt) do { __builtin_amdgcn_s_setprio(1); _Pragma("unroll") for (int m = 0; m < 4; ++m) _Pragma("unroll") for (int n = 0; n < 2; ++n) _Pragma("unroll") for (int k = 0; k < 2; ++k) \
        acc[ai][bj][m][n] = __builtin_amdgcn_mfma_f32_16x16x32_bf16(Bt[n][k], At[m][k], acc[ai][bj][m][n], 0, 0, 0); __builtin_amdgcn_s_setprio(0); } while (0)
#define PG8_WAIT_V(n) asm volatile("s_waitcnt vmcnt(" #n ")" ::: "memory")
#define PG8_WAIT_L(n) asm volatile("s_waitcnt lgkmcnt(" #n ")" ::: "memory")
#define PG8_BAR __builtin_amdgcn_s_barrier()
#define PG8_SCHED __builtin_amdgcn_sched_barrier(0)
    Unit cur, nxt; int ui = 0;
    if (!S.next(0, cur)) return;
    f32x4 acc[2][2][4][2];
#pragma unroll
    for (int a = 0; a < 2; ++a)
#pragma unroll
        for (int b = 0; b < 2; ++b)
#pragma unroll
            for (int m = 0; m < 4; ++m)
#pragma unroll
                for (int n = 0; n < 2; ++n) acc[a][b][m][n] = (f32x4){0.f, 0.f, 0.f, 0.f};
    bf16x8 At[4][2], B0[2][2], B1[2][2];
    const char* cA = (const char*)g.A + (size_t)cur.pm * tstep; const char* cB = (const char*)g.Bt + (size_t)cur.pn * tstep;
    S.a_ready(cur);
    if constexpr (SP2) {
        PG8_STAGE(PG8_SB(0, 0), cB, voffB); PG8_STAGE(PG8_SB(0, 1), cB + hstep, voffB); PG8_STAGE(PG8_SA(0, 0), cA, voffA); PG8_STAGE(PG8_SA(0, 1), cA + hstep, voffA);
        if (wr == 1) PG8_BAR;
        PG8_WAIT_V(2); PG8_BAR;
        PG8_STAGE(PG8_SB(1, 0), cB + kstep, voffB); PG8_STAGE(PG8_SA(1, 0), cA + kstep, voffA); PG8_STAGE(PG8_SB(1, 1), cB + hstep + kstep, voffB);
        PG8_WAIT_V(6); PG8_BAR;
    } else {
        PG8_STAGE(PG8_SB(0, 0), cB, voffB); PG8_STAGE(PG8_SA(0, 0), cA, voffA); PG8_STAGE(PG8_SB(0, 1), cB + hstep, voffB); PG8_STAGE(PG8_SA(0, 1), cA + hstep, voffA);
        if (wr == 1) PG8_BAR;
        PG8_WAIT_V(4); PG8_BAR;
        PG8_STAGE(PG8_SB(1, 0), cB + kstep, voffB); PG8_STAGE(PG8_SA(1, 0), cA + kstep, voffA); PG8_STAGE(PG8_SB(1, 1), cB + hstep + kstep, voffB);
        PG8_WAIT_V(6); PG8_BAR;
    }
    for (;;) {
        const bool has_next = S.next(ui + 1, nxt);
        const char* nA = has_next ? (const char*)g.A + (size_t)nxt.pm * tstep : cA; const char* nB = has_next ? (const char*)g.Bt + (size_t)nxt.pn * tstep : cB;
        for (int t = 0; t < nt; t += 2) {
            const bool last = (t == nt - 2);
            const char* a1 = cA + (size_t)(t + 1) * kstep;
            const char* a2 = last ? nA : cA + (size_t)(t + 2) * kstep; const char* b2 = last ? nB : cB + (size_t)(t + 2) * kstep;
            const char* a3 = a2 + kstep; const char* b3 = b2 + kstep;
            if (last && has_next) S.a_ready(nxt);
            if constexpr (SP2) {
            PG8_LDB(B0, 0, 0); PG8_LDB(B1, 0, 1); PG8_SCHED; PG8_LDA(At, 0, 0); PG8_STAGE(PG8_SA(1, 1), a1 + hstep, voffA);
            PG8_WAIT_V(8); PG8_WAIT_L(0); PG8_BAR; PG8_MMA(0, 0, At, B0); PG8_MMA(0, 1, At, B1); PG8_BAR; PG8_SCHED;
            PG8_LDA(At, 0, 1); PG8_STAGE(PG8_SB(0, 0), b2, voffB); PG8_STAGE(PG8_SB(0, 1), b2 + hstep, voffB); PG8_STAGE(PG8_SA(0, 0), a2, voffA);
            PG8_WAIT_V(8); PG8_WAIT_L(0); PG8_BAR; PG8_MMA(1, 0, At, B0); PG8_MMA(1, 1, At, B1); PG8_BAR; PG8_SCHED;
            PG8_LDB(B0, 1, 0); PG8_LDB(B1, 1, 1); PG8_SCHED; PG8_LDA(At, 1, 0); PG8_STAGE(PG8_SA(0, 1), a2 + hstep, voffA);
            PG8_WAIT_V(8); PG8_WAIT_L(0); PG8_BAR; PG8_MMA(0, 0, At, B0); PG8_MMA(0, 1, At, B1); PG8_BAR; PG8_SCHED;
            PG8_LDA(At, 1, 1); PG8_STAGE(PG8_SB(1, 0), b3, voffB); PG8_STAGE(PG8_SB(1, 1), b3 + hstep, voffB); PG8_STAGE(PG8_SA(1, 0), a3, voffA);
            PG8_WAIT_V(8); PG8_WAIT_L(0); PG8_BAR; PG8_MMA(1, 0, At, B0); PG8_MMA(1, 1, At, B1); PG8_BAR; PG8_SCHED;
            } else {
            PG8_LDB(B0, 0, 0); PG8_SCHED; PG8_LDA(At, 0, 0); PG8_STAGE(PG8_SA(1, 1), a1 + hstep, voffA);
            PG8_WAIT_L(8); PG8_BAR; PG8_WAIT_L(0); PG8_MMA(0, 0, At, B0); PG8_BAR; PG8_SCHED;
            PG8_LDB(B1, 0, 1); PG8_STAGE(PG8_SB(0, 0), b2, voffB);
            PG8_BAR; PG8_WAIT_L(0); PG8_MMA(0, 1, At, B1); PG8_BAR;
            PG8_LDA(At, 0, 1); PG8_STAGE(PG8_SA(0, 0), a2, voffA);
            PG8_BAR; PG8_WAIT_L(0); PG8_MMA(1, 0, At, B0); PG8_BAR; PG8_SCHED;
            PG8_STAGE(PG8_SB(0, 1), b2 + hstep, voffB);
            PG8_WAIT_V(6); PG8_BAR; PG8_MMA(1, 1, At, B1); PG8_BAR;
            PG8_LDB(B0, 1, 0); PG8_SCHED; PG8_LDA(At, 1, 0); PG8_STAGE(PG8_SA(0, 1), a2 + hstep, voffA);
            PG8_WAIT_L(8); PG8_BAR; PG8_WAIT_L(0); PG8_MMA(0, 0, At, B0); PG8_BAR; PG8_SCHED;
            PG8_LDB(B1, 1, 1); PG8_STAGE(PG8_SB(1, 0), b3, voffB);
            PG8_BAR; PG8_WAIT_L(0); PG8_MMA(0, 1, At, B1); PG8_BAR;
            PG8_LDA(At, 1, 1); PG8_STAGE(PG8_SA(1, 0), a3, voffA);
            PG8_BAR; PG8_WAIT_L(0); PG8_MMA(1, 0, At, B0); PG8_BAR; PG8_SCHED;
            PG8_STAGE(PG8_SB(1, 1), b3 + hstep, voffB);
            PG8_WAIT_V(6); PG8_BAR; PG8_MMA(1, 1, At, B1); PG8_BAR;
            }
        }
        if constexpr (ALIGN_EPI) { if (wr == 0) PG8_BAR; }
        if constexpr (!Epi::AFTER_DRAIN) { E(acc, cur, wr, wc, fr, fq); S.done(cur); }
        if (!has_next) break;
#pragma unroll
        for (int a = 0; a < 2; ++a)
#pragma unroll
            for (int b = 0; b < 2; ++b)
#pragma unroll
                for (int m = 0; m < 4; ++m)
#pragma unroll
                    for (int n = 0; n < 2; ++n) acc[a][b][m][n] = (f32x4){0.f, 0.f, 0.f, 0.f};
        cur = nxt; cA = nA; cB = nB; ++ui;
        if constexpr (ALIGN_EPI) { if (wr == 1) PG8_BAR; }
    }
    PG8_WAIT_V(0);
    if constexpr (!ALIGN_EPI) { if (wr == 0) PG8_BAR; }
    PG8_BAR;
    if constexpr (Epi::AFTER_DRAIN) { E.fused(acc, cur, wr, wc, fr, fq, lds, wid, lane); S.done(cur); }
#undef PG8_SA
#undef PG8_SB
#undef PG8_STAGE
#undef PG8_LDA
#undef PG8_LDB
#undef PG8_MMA
#undef PG8_WAIT_V
#undef PG8_WAIT_L
#undef PG8_BAR
#undef PG8_SCHED
}
}

#define LAS __attribute__((address_space(3)))
#define DI __device__ __forceinline__
using pg8::bf16_t; using pg8::bf16x8; using pg8::f32x4; using pg8::u32x4;
typedef short s16x4 __attribute__((ext_vector_type(4)));
typedef float f32x16 __attribute__((ext_vector_type(16)));
typedef float f32x2 __attribute__((ext_vector_type(2)));
typedef unsigned u32x2 __attribute__((ext_vector_type(2)));
typedef __bf16 bf16x2_t __attribute__((ext_vector_type(2)));

constexpr int NBATCH = 4, SEQ = 4096, CTXL = 256, TPB = 4352, MROWS = NBATCH * TPB, DM = 1024, DFF = 2816, DEPTH = 4, MODW = 6 * DM;
constexpr float ALPHA = 1.6817928305074290f, LOG2E = 1.4426950408889634f;
constexpr size_t MiB = 1048576;
constexpr size_t WS_MOD = 0, WS_ROPEA = 512 * 1024, WS_ROPEC = WS_ROPEA + 16384, WS_XC = 1 * MiB, WS_H = 5 * MiB, WS_W = 39 * MiB;
constexpr size_t WS_WGU(int l) { return WS_W + (size_t)l * (33 * MiB / 2); }
constexpr size_t WS_WD(int l) { return WS_WGU(l) + 11 * MiB; }
constexpr size_t WS_WA_QKV(int j) { return WS_W + 66 * MiB + (size_t)j * 5 * MiB; }
constexpr size_t WS_WA_O(int j) { return WS_WA_QKV(j) + 3 * MiB; }
constexpr size_t WS_WB_QKV = WS_W + 76 * MiB, WS_WB_O = WS_WB_QKV + 6 * MiB;
constexpr size_t WS_WC_DQKV = WS_W + 84 * MiB, WS_WC_UQ = WS_WC_DQKV + 3 * MiB / 2, WS_WC_UKV = WS_WC_UQ + 9 * MiB / 8, WS_WC_O = WS_WC_UKV + 1 * MiB;
constexpr size_t WS_R = 129 * MiB;
constexpr size_t WS_AQ = WS_R, WS_AK = WS_R + 34 * MiB, WS_AV = WS_AK + 17 * MiB / 2;
constexpr size_t WS_BQ = WS_R, WS_BK = WS_R + 34 * MiB, WS_BV = WS_R + 68 * MiB;
constexpr size_t WS_CQ = WS_R, WS_CKV = WS_R + 51 * MiB, WS_CKR = WS_R + 119 * MiB, WS_CQL = WS_R + 122 * MiB, WS_CKVL = WS_R + 135 * MiB;
constexpr size_t WS_ACT = WS_R;
constexpr size_t WS_END = WS_R + 144 * MiB;
static_assert(WS_WC_O + 2 * MiB <= WS_R, "weights fit");

constexpr int LDS_BYTES = 147456;

struct Params { const float* in[24]; float* out; unsigned char* ws; int ph_lo, ph_hi; };
typedef const __attribute__((address_space(4))) unsigned char* kaptr;
DI const float* KIN(kaptr ka, int i) { return *(const float* const __attribute__((address_space(4)))*)(ka + 8 * i); }
DI float* KOUT(kaptr ka) { return *(float* const __attribute__((address_space(4)))*)(ka + 192); }
DI unsigned char* KWS(kaptr ka) { return *(unsigned char* const __attribute__((address_space(4)))*)(ka + 200); }

DI unsigned pk2(float lo, float hi) { f32x2 v = {lo, hi}; return __builtin_bit_cast(unsigned, __builtin_convertvector(v, bf16x2_t)); }
DI float bflo(unsigned u) { return __uint_as_float(u << 16); }
DI float bfhi(unsigned u) { return __uint_as_float(u & 0xffff0000u); }
DI void unpack8(const u32x4 w, float (&f)[8]) { f[0] = bflo(w.x); f[1] = bfhi(w.x); f[2] = bflo(w.y); f[3] = bfhi(w.y); f[4] = bflo(w.z); f[5] = bfhi(w.z); f[6] = bflo(w.w); f[7] = bfhi(w.w); }
DI u32x4 pack8(const float (&f)[8]) { u32x4 w; w.x = pk2(f[0], f[1]); w.y = pk2(f[2], f[3]); w.z = pk2(f[4], f[5]); w.w = pk2(f[6], f[7]); return w; }
DI float wave_sum(float v) {
#pragma unroll
    for (int o = 1; o < 64; o <<= 1) v += __shfl_xor(v, o);
    return v;
}
DI float silu_f(float x) { return x * __builtin_amdgcn_rcpf(1.0f + __expf(-x)); }

struct EpiStore {
    static constexpr bool PERM = true, AFTER_DRAIN = false;
    bf16_t* p2; long long d12, d01; int ld2, dl12, dl01, c1, c2, nvalid;
    static DI EpiStore make(bf16_t* p0, bf16_t* p1, bf16_t* p2, int c1, int c2, int ld0, int ld1, int ld2, int nvalid) {
        EpiStore e; e.p2 = p2; e.d12 = (long long)(p1 - p2); e.d01 = (long long)(p0 - p1); e.ld2 = ld2; e.dl12 = ld1 - ld2; e.dl01 = ld0 - ld1; e.c1 = c1; e.c2 = c2; e.nvalid = nvalid; return e; }
    DI void operator()(const f32x4 (&acc)[2][2][4][2], const pg8::Unit& u, int wr, int wc, int fr, int fq) const {
        const int row0 = u.pm * 256 + wr * 64 + fr;
#pragma unroll
        for (int bj = 0; bj < 2; ++bj) {
            const int col = u.pn * 256 + bj * 128 + wc * 32 + 8 * fq;
            const int m0 = -(int)(col < c1), m1 = -(int)(col < c2);
            bf16_t* base = p2 + ((d12 & (long long)m1) + (d01 & (long long)m0));
            const int ld = ld2 + (dl12 & m1) + (dl01 & m0), lc = col - c2 + ((c2 - c1) & m1) + (c1 & m0);
            if (col < nvalid) {
#pragma unroll
                for (int ai = 0; ai < 2; ++ai)
#pragma unroll
                    for (int m = 0; m < 4; ++m) {
                        const f32x4 v0 = acc[ai][bj][m][0], v1 = acc[ai][bj][m][1];
                        u32x4 w; w.x = pk2(v0[0], v0[1]); w.y = pk2(v0[2], v0[3]); w.z = pk2(v1[0], v1[1]); w.w = pk2(v1[2], v1[3]);
                        *(u32x4*)(base + (size_t)(row0 + ai * 128 + m * 16) * ld + lc) = w;
                    }
            }
        }
    }
};
struct EpiResid {
    static constexpr bool PERM = true, AFTER_DRAIN = false;
    float* xlat; float* xctx; const float* gate;
    DI void operator()(const f32x4 (&acc)[2][2][4][2], const pg8::Unit& u, int wr, int wc, int fr, int fq) const {
        const int b = u.pm / 17, t = u.pm - b * 17;
        float* xb = (t == 16) ? xctx + (size_t)b * 256 * DM : xlat + ((size_t)b * 4096 + t * 256) * DM;
        const float* g = gate + (size_t)((t == 16) ? 4 : b) * MODW;
        const int rl = wr * 64 + fr;
#pragma unroll
        for (int bj = 0; bj < 2; ++bj) {
            const int col = u.pn * 256 + bj * 128 + wc * 32 + 8 * fq;
            const f32x4 g0 = *(const f32x4*)(g + col), g1 = *(const f32x4*)(g + col + 4);
#pragma unroll
            for (int ai = 0; ai < 2; ++ai) {
#pragma unroll
                for (int m = 0; m < 4; ++m) {
                    float* xp = xb + (size_t)(rl + ai * 128 + m * 16) * DM + col;
                    const f32x4 x0 = *(const f32x4*)xp, x1 = *(const f32x4*)(xp + 4);
                    *(f32x4*)xp = x0 * ALPHA + g0 * acc[ai][bj][m][0];
                    *(f32x4*)(xp + 4) = x1 * ALPHA + g1 * acc[ai][bj][m][1];
                }
                asm volatile("" ::: "memory");
            }
        }
    }
};
struct EpiSwiGLU {
    static constexpr bool PERM = true, AFTER_DRAIN = false;
    bf16_t* act;
    DI void operator()(const f32x4 (&acc)[2][2][4][2], const pg8::Unit& u, int wr, int wc, int fr, int fq) const {
        const int row0 = u.pm * 256 + wr * 64 + fr, col = u.pn * 128 + wc * 32 + 8 * fq;
#pragma unroll
        for (int ai = 0; ai < 2; ++ai)
#pragma unroll
            for (int m = 0; m < 4; ++m) {
                const f32x4 a0 = acc[ai][0][m][0], a1 = acc[ai][0][m][1], b0 = acc[ai][1][m][0], b1 = acc[ai][1][m][1];
                u32x4 w;
                w.x = pk2(silu_f(a0[0]) * b0[0], silu_f(a0[1]) * b0[1]); w.y = pk2(silu_f(a0[2]) * b0[2], silu_f(a0[3]) * b0[3]);
                w.z = pk2(silu_f(a1[0]) * b1[0], silu_f(a1[1]) * b1[1]); w.w = pk2(silu_f(a1[2]) * b1[2], silu_f(a1[3]) * b1[3]);
                *(u32x4*)(act + (size_t)(row0 + ai * 128 + m * 16) * DFF + col) = w;
            }
    }
};
template <class Epi> DI void run_gemm(LAS unsigned char* lds, const bf16_t* A, const bf16_t* Bt, int M, int N, int K, const Epi& E) {
    pg8::Gemm g{A, Bt, M, N, K}; pg8::StaticOrder S; S.init(M, N, (int)gridDim.x, bidx());
    pg8::gemm_phase<Epi, pg8::StaticOrder, true, true>(lds, g, S, E);
}

struct AttnArgs { const bf16_t* Q; const bf16_t* K; const bf16_t* V; const bf16_t* K2; bf16_t* O; const float* gain; const float* rpb; const f32x2* rope; };
DI int crow(int i, int h) { return (i & 3) + 8 * (i >> 2) + 4 * h; }

template <int MODE> DI void attn_phase(LAS unsigned char* lds, const AttnArgs a) {
    constexpr int DK = MODE == 0 ? 128 : (MODE == 1 ? 64 : 192), DV = MODE == 1 ? 64 : 128;
    constexpr int KT = MODE == 0 ? 128 : (MODE == 1 ? 256 : 192), VT = MODE == 1 ? 256 : 128;
    constexpr int KSTR = KT * 2 + 16, VSTR = VT * 2 + 64, VOFF = 64 * KSTR, BOFF = VOFF + 64 * VSTR;
    constexpr int KCH = KT / 8, VCH = VT / 8, NKC = KT / 64, NVC = VT / 64, NS = DK / 16, NVB = DV / 32;
    constexpr int QLD = MODE == 2 ? 1536 : 1024;
    constexpr float QS = (MODE == 0 ? 0.08838834764831845f : (MODE == 1 ? 0.125f : 0.07216878364870322f)) * LOG2E;
    const int tid = tidx(), lane = tid & 63, w = __builtin_amdgcn_readfirstlane(tid >> 6), r = lane & 31, h = lane >> 5;
    const int nunits = MODE == 1 ? 1088 : 544;
    const int kc0 = MODE == 1 ? 64 * (w >> 1) : 0;
    for (int u = bidx(); u < nunits; u += gridDim.x) {
        int b, head, hq = 0, qpos, nloc, base0, ntiles, rr = 0, rs = 0;
        if (MODE == 1) {
            if (u < 1024) { b = u >> 8; rr = (u >> 2) & 63; hq = u & 3; qpos = rr * 64 + 32 * (w & 1) + r; rs = min(max(rr - 4, 0), 56); nloc = 8; base0 = rs * 64; ntiles = 12; }
            else { const int v = u - 1024; b = v >> 4; hq = v & 3; qpos = 4096 + ((v >> 2) & 3) * 64 + 32 * (w & 1) + r; nloc = 0; base0 = 0; ntiles = 4; }
            head = 4 * hq + (w >> 1);
        } else {
            if (u < 512) { b = u >> 7; head = (u >> 4) & 7; qpos = (u & 15) * 256 + 32 * w + r; nloc = 68; base0 = 0; ntiles = 68; }
            else { const int v = u - 512; b = v >> 3; head = v & 7; qpos = 4096 + 32 * w + r; nloc = 0; base0 = 0; ntiles = 4; }
        }
        const int kvh = head >> 2;
        const size_t rowb = (size_t)b * TPB;
        const bool lat = qpos < 4096;
        bf16x8 qf[NS];
        {
            const bf16_t* qp = a.Q + (rowb + qpos) * QLD + head * DK + 8 * h;
            u32x4 qraw[NS];
#pragma unroll
            for (int s = 0; s < NS; ++s) qraw[s] = *(const u32x4*)(qp + 16 * s);
            if (MODE == 0) {
                float ss = 0.f;
#pragma unroll
                for (int s = 0; s < NS; ++s) { float f[8]; unpack8(qraw[s], f);
#pragma unroll
                    for (int e = 0; e < 8; ++e) ss += f[e] * f[e]; }
                ss += __shfl_xor(ss, 32);
                const float rstd = rsqrtf(ss * (1.0f / 128.0f) + 1e-6f) * QS;
                const int pr = qpos >> 6, pc = qpos & 63;
#pragma unroll
                for (int g = 0; g < 4; ++g) {
                    const int s0 = (g & 1) + 4 * (g >> 1), s1 = s0 + 2, pos = (g >> 1) ? pc : pr, i0 = 16 * (g & 1) + 8 * h;
                    float t1[8], t2[8], o1[8], o2[8]; unpack8(qraw[s0], t1); unpack8(qraw[s1], t2);
                    const float* g1 = a.gain + 16 * s0 + 8 * h; const float* g2 = a.gain + 16 * s1 + 8 * h;
#pragma unroll
                    for (int e = 0; e < 8; ++e) {
                        f32x2 cs = a.rope[pos * 32 + i0 + e]; if (!lat) { cs.x = 1.f; cs.y = 0.f; }
                        const float x1 = t1[e] * rstd * g1[e], x2 = t2[e] * rstd * g2[e];
                        o1[e] = x1 * cs.x - x2 * cs.y; o2[e] = x2 * cs.x + x1 * cs.y;
                    }
                    qraw[s0] = pack8(o1); qraw[s1] = pack8(o2);
                }
            } else if (MODE == 1) {
#pragma unroll
                for (int s = 0; s < NS; ++s) { float f[8]; unpack8(qraw[s], f);
#pragma unroll
                    for (int e = 0; e < 8; ++e) f[e] *= QS;
                    qraw[s] = pack8(f); }
            } else {
#pragma unroll
                for (int s = 0; s < 8; ++s) { float f[8]; unpack8(qraw[s], f);
#pragma unroll
                    for (int e = 0; e < 8; ++e) f[e] *= QS;
                    qraw[s] = pack8(f); }
                const int pr = qpos >> 6, pc = qpos & 63;
#pragma unroll
                for (int g = 0; g < 2; ++g) {
                    const int s0 = 8 + 2 * g, s1 = s0 + 1, pos = g ? pc : pr;
                    float t1[8], t2[8], o1[8], o2[8]; unpack8(qraw[s0], t1); unpack8(qraw[s1], t2);
#pragma unroll
                    for (int e = 0; e < 8; ++e) {
                        f32x2 cs = a.rope[pos * 16 + 8 * h + e]; if (!lat) { cs.x = 1.f; cs.y = 0.f; }
                        const float x1 = t1[e] * QS, x2 = t2[e] * QS;
                        o1[e] = x1 * cs.x - x2 * cs.y; o2[e] = x2 * cs.x + x1 * cs.y;
                    }
                    qraw[s0] = pack8(o1); qraw[s1] = pack8(o2);
                }
            }
#pragma unroll
            for (int s = 0; s < NS; ++s) qf[s] = __builtin_bit_cast(bf16x8, qraw[s]);
        }
        __syncthreads();
        if (MODE == 1 && nloc > 0) {
            LAS float* bl = (LAS float*)(lds + BOFF);
            for (int t = tid; t < 4 * 465; t += 512) bl[t] = a.rpb[(size_t)(4 * hq) * 465 + t] * LOG2E;
        }
        f32x16 oacc[NVB];
#pragma unroll
        for (int vb = 0; vb < NVB; ++vb)
#pragma unroll
            for (int i = 0; i < 16; ++i) oacc[vb][i] = 0.f;
        float mrun = -1e30f, lrun = 0.f;
        u32x4 kreg[NKC], vreg[NVC];
#define ATT_LOAD_TILE(kp) do { \
        _Pragma("unroll") for (int i_ = 0; i_ < NKC; ++i_) { const int ci = tid + 512 * i_, kr = ci / KCH, cc = ci - kr * KCH; const size_t row = rowb + (kp) + kr; const bf16_t* src; \
            if (MODE == 0) src = a.K + row * 256 + kvh * 128 + cc * 8; else if (MODE == 1) src = a.K + row * 1024 + hq * 256 + cc * 8; \
            else src = (cc < 16) ? a.K + row * 2048 + head * 256 + cc * 8 : a.K2 + row * 64 + (cc - 16) * 8; \
            kreg[i_] = *(const u32x4*)src; } \
        _Pragma("unroll") for (int i_ = 0; i_ < NVC; ++i_) { const int ci = tid + 512 * i_, kr = ci / VCH, cc = ci - kr * VCH; const size_t row = rowb + (kp) + kr; const bf16_t* src; \
            if (MODE == 0) src = a.V + row * 256 + kvh * 128 + cc * 8; else if (MODE == 1) src = a.V + row * 1024 + hq * 256 + cc * 8; \
            else src = a.V + row * 2048 + head * 256 + 128 + cc * 8; \
            vreg[i_] = *(const u32x4*)src; } } while (0)
        ATT_LOAD_TILE(nloc > 0 ? base0 : 4096);
        for (int j = 0; j < ntiles; ++j) {
            __syncthreads();
#pragma unroll
            for (int i_ = 0; i_ < NKC; ++i_) { const int ci = tid + 512 * i_, kr = ci / KCH, cc = ci - kr * KCH; *(LAS u32x4*)(lds + kr * KSTR + cc * 16) = kreg[i_]; }
#pragma unroll
            for (int i_ = 0; i_ < NVC; ++i_) { const int ci = tid + 512 * i_, kr = ci / VCH, cc = ci - kr * VCH; *(LAS u32x4*)(lds + VOFF + kr * VSTR + cc * 16) = vreg[i_]; }
            __syncthreads();
            if (j + 1 < ntiles) { const int jn = j + 1; const int kpn = jn < nloc ? base0 + 64 * jn : 4096 + 64 * (jn - nloc); ATT_LOAD_TILE(kpn); }
            f32x16 sacc[2];
#pragma unroll
            for (int kb = 0; kb < 2; ++kb) {
#pragma unroll
                for (int i = 0; i < 16; ++i) sacc[kb][i] = 0.f;
#pragma unroll
                for (int s = 0; s < NS; ++s) {
                    const bf16x8 kf = *(const LAS bf16x8*)(lds + (32 * kb + r) * KSTR + (kc0 + 16 * s + 8 * h) * 2);
                    sacc[kb] = __builtin_amdgcn_mfma_f32_32x32x16_bf16(kf, qf[s], sacc[kb], 0, 0, 0);
                }
                asm volatile("" ::: "memory");
            }
            if (MODE == 1 && j < nloc) {
                const int c = qpos & 63, cs = min(max(c - 8, 0), 48), dr = rs + j - rr + 7;
                const LAS float* bl = (const LAS float*)(lds + BOFF) + ((w >> 1) * 15 + dr) * 31 + 15 - c;
#pragma unroll
                for (int kb = 0; kb < 2; ++kb)
#pragma unroll
                    for (int i = 0; i < 16; ++i) {
                        const int jc = 32 * kb + crow(i, h); const bool ok = (jc >= cs) && (jc <= cs + 15);
                        const float bias = bl[ok ? jc : c];
                        sacc[kb][i] = ok ? sacc[kb][i] + bias : -1e30f;
                    }
            }
            float mx = sacc[0][0];
#pragma unroll
            for (int kb = 0; kb < 2; ++kb)
#pragma unroll
                for (int i = 0; i < 16; ++i) mx = fmaxf(mx, sacc[kb][i]);
            mx = fmaxf(mx, __shfl_xor(mx, 32));
            const float mnew = fmaxf(mrun, mx), alpha = __builtin_amdgcn_exp2f(mrun - mnew);
            mrun = mnew;
            float sum = 0.f;
#pragma unroll
            for (int kb = 0; kb < 2; ++kb)
#pragma unroll
                for (int i = 0; i < 16; ++i) { const float p = __builtin_amdgcn_exp2f(sacc[kb][i] - mnew); sacc[kb][i] = p; sum += p; }
            sum += __shfl_xor(sum, 32);
            lrun = lrun * alpha + sum;
#pragma unroll
            for (int vb = 0; vb < NVB; ++vb)
#pragma unroll
                for (int i = 0; i < 16; ++i) oacc[vb][i] *= alpha;
            bf16x8 pf[4];
#pragma unroll
            for (int t = 0; t < 4; ++t) {
                const int kb = t >> 1, o = 8 * (t & 1);
                u32x4 pw; pw.x = pk2(sacc[kb][o], sacc[kb][o + 1]); pw.y = pk2(sacc[kb][o + 2], sacc[kb][o + 3]); pw.z = pk2(sacc[kb][o + 4], sacc[kb][o + 5]); pw.w = pk2(sacc[kb][o + 6], sacc[kb][o + 7]);
                pf[t] = __builtin_bit_cast(bf16x8, pw);
            }
            {
                const int i16 = lane & 15, q4 = i16 >> 2, p4 = i16 & 3, g1 = (lane >> 4) & 1;
                LAS unsigned char* vbase = lds + VOFF + (4 * h + q4) * VSTR + (kc0 + 16 * g1) * 2 + 8 * p4;
#pragma unroll
                for (int vb = 0; vb < NVB; ++vb)
#pragma unroll
                    for (int t = 0; t < 4; ++t) {
                        const s16x4 lo = __builtin_amdgcn_ds_read_tr16_b64_v4i16((LAS s16x4*)(vbase + (16 * t) * VSTR + 64 * vb));
                        const s16x4 hi = __builtin_amdgcn_ds_read_tr16_b64_v4i16((LAS s16x4*)(vbase + (16 * t + 8) * VSTR + 64 * vb));
                        const bf16x8 va = __builtin_shufflevector(lo, hi, 0, 1, 2, 3, 4, 5, 6, 7);
                        oacc[vb] = __builtin_amdgcn_mfma_f32_32x32x16_bf16(va, pf[t], oacc[vb], 0, 0, 0);
                    }
            }
        }
#undef ATT_LOAD_TILE
        {
            const float inv = 1.0f / lrun;
            bf16_t* op = a.O + (rowb + qpos) * 1024 + head * DV + 4 * h;
#pragma unroll
            for (int vb = 0; vb < NVB; ++vb)
#pragma unroll
                for (int g = 0; g < 4; ++g) {
                    u32x2 wv; wv.x = pk2(oacc[vb][4 * g] * inv, oacc[vb][4 * g + 1] * inv); wv.y = pk2(oacc[vb][4 * g + 2] * inv, oacc[vb][4 * g + 3] * inv);
                    *(u32x2*)(op + 32 * vb + 8 * g) = wv;
                }
        }
    }
    __syncthreads();
}

DI float* xrow_ptr(float* xlat, float* xctx, int m) { const int b = m / TPB, pos = m - b * TPB; return pos < 4096 ? xlat + ((size_t)b * 4096 + pos) * DM : xctx + ((size_t)b * 256 + (pos - 4096)) * DM; }
DI int modrow(int m) { const int b = m / TPB, pos = m - b * TPB; return pos < 4096 ? b : 4; }

template <bool LN> DI void rows_phase(kaptr p, const float* lng, const float* lnb, const float* modp, bool write_h) {
    const int lane = tidx() & 63, gw = bidx() * 8 + (tidx() >> 6), NGW = gridDim.x * 8;
    float* xlat = KOUT(p); float* xctx = (float*)(KWS(p) + WS_XC); bf16_t* H = (bf16_t*)(KWS(p) + WS_H);
    for (int m = gw; m < MROWS; m += NGW) {
        float* xr = xrow_ptr(xlat, xctx, m);
        const float* src = xr;
        if (!LN) { const int b = m / TPB, pos = m - b * TPB; src = pos < 4096 ? KIN(p, 0) + ((size_t)b * 4096 + pos) * DM : KIN(p, 2) + ((size_t)b * 256 + (pos - 4096)) * DM; }
        f32x4 v[4];
#pragma unroll
        for (int j = 0; j < 4; ++j) v[j] = *(const f32x4*)(src + 4 * lane + 256 * j);
        if (LN) {
            float s = 0.f;
#pragma unroll
            for (int j = 0; j < 4; ++j) s += (v[j].x + v[j].y) + (v[j].z + v[j].w);
            const float mean = wave_sum(s) * (1.0f / DM);
            float s2 = 0.f;
#pragma unroll
            for (int j = 0; j < 4; ++j) { v[j] = v[j] - mean; s2 += (v[j].x * v[j].x + v[j].y * v[j].y) + (v[j].z * v[j].z + v[j].w * v[j].w); }
            const float rstd = rsqrtf(wave_sum(s2) * (1.0f / DM) + 1e-5f);
#pragma unroll
            for (int j = 0; j < 4; ++j) { const f32x4 g = *(const f32x4*)(lng + 4 * lane + 256 * j), bb = *(const f32x4*)(lnb + 4 * lane + 256 * j); v[j] = v[j] * rstd * g + bb; }
        }
#pragma unroll
        for (int j = 0; j < 4; ++j) *(f32x4*)(xr + 4 * lane + 256 * j) = v[j];
        if (write_h) {
            const float* mp = modp + (size_t)modrow(m) * MODW;
#pragma unroll
            for (int j = 0; j < 4; ++j) {
                const f32x4 sh = *(const f32x4*)(mp + 4 * lane + 256 * j), sc = *(const f32x4*)(mp + DM + 4 * lane + 256 * j);
                const f32x4 hh = v[j] * (sc + 1.0f) + sh;
                u32x2 wv; wv.x = pk2(hh.x, hh.y); wv.y = pk2(hh.z, hh.w);
                *(u32x2*)(H + (size_t)m * DM + 4 * lane + 256 * j) = wv;
            }
        }
    }
}

DI void kpost_a(kaptr p, const float* kgain) {
    bf16_t* K = (bf16_t*)(KWS(p) + WS_AK); const f32x2* rope = (const f32x2*)(KWS(p) + WS_ROPEA);
    const int lane = tidx() & 63, j16 = lane & 15, sub = lane >> 4, gw = bidx() * 8 + (tidx() >> 6), NGW = gridDim.x * 8;
    for (int it = gw; it < MROWS * 2 / 4; it += NGW) {
        const int item = it * 4 + sub, m = item >> 1, kvh = item & 1;
        const int b = m / TPB, pos = m - b * TPB; const bool lat = pos < 4096;
        unsigned* kp = (unsigned*)(K + (size_t)m * 256 + kvh * 128) + j16;
        float v[4][2]; float ss = 0.f;
#pragma unroll
        for (int k = 0; k < 4; ++k) { const unsigned wv = kp[16 * k]; v[k][0] = bflo(wv); v[k][1] = bfhi(wv); ss += v[k][0] * v[k][0] + v[k][1] * v[k][1]; }
        ss += __shfl_xor(ss, 1); ss += __shfl_xor(ss, 2); ss += __shfl_xor(ss, 4); ss += __shfl_xor(ss, 8);
        const float rstd = rsqrtf(ss * (1.0f / 128.0f) + 1e-6f);
#pragma unroll
        for (int k = 0; k < 4; ++k) { v[k][0] *= rstd * kgain[32 * k + 2 * j16]; v[k][1] *= rstd * kgain[32 * k + 2 * j16 + 1]; }
        if (lat) {
            const int pr = pos >> 6, pc = pos & 63;
#pragma unroll
            for (int g = 0; g < 2; ++g)
#pragma unroll
                for (int e = 0; e < 2; ++e) {
                    const f32x2 cs = rope[(g ? pc : pr) * 32 + 2 * j16 + e];
                    const float t1 = v[2 * g][e], t2 = v[2 * g + 1][e];
                    v[2 * g][e] = t1 * cs.x - t2 * cs.y; v[2 * g + 1][e] = t2 * cs.x + t1 * cs.y;
                }
        }
#pragma unroll
        for (int k = 0; k < 4; ++k) kp[16 * k] = pk2(v[k][0], v[k][1]);
    }
}
DI void post_c(kaptr p, const float* qg, const float* kvg) {
    bf16_t* QL = (bf16_t*)(KWS(p) + WS_CQL); bf16_t* KVL = (bf16_t*)(KWS(p) + WS_CKVL); bf16_t* KR = (bf16_t*)(KWS(p) + WS_CKR); const f32x2* rope = (const f32x2*)(KWS(p) + WS_ROPEC);
    const int lane = tidx() & 63, gw = bidx() * 8 + (tidx() >> 6), NGW = gridDim.x * 8;
    for (int m = gw; m < MROWS; m += NGW) {
        const int b = m / TPB, pos = m - b * TPB;
        {   unsigned* qp = (unsigned*)(QL + (size_t)m * 384) + lane; float v[3][2]; float ss = 0.f;
#pragma unroll
            for (int k = 0; k < 3; ++k) { const unsigned wv = qp[64 * k]; v[k][0] = bflo(wv); v[k][1] = bfhi(wv); ss += v[k][0] * v[k][0] + v[k][1] * v[k][1]; }
            const float rstd = rsqrtf(wave_sum(ss) * (1.0f / 384.0f) + 1e-6f);
#pragma unroll
            for (int k = 0; k < 3; ++k) qp[64 * k] = pk2(v[k][0] * rstd * qg[128 * k + 2 * lane], v[k][1] * rstd * qg[128 * k + 2 * lane + 1]); }
        {   unsigned* kp = (unsigned*)(KVL + (size_t)m * 256) + lane; float v[2][2]; float ss = 0.f;
#pragma unroll
            for (int k = 0; k < 2; ++k) { const unsigned wv = kp[64 * k]; v[k][0] = bflo(wv); v[k][1] = bfhi(wv); ss += v[k][0] * v[k][0] + v[k][1] * v[k][1]; }
            const float rstd = rsqrtf(wave_sum(ss) * (1.0f / 256.0f) + 1e-6f);
#pragma unroll
            for (int k = 0; k < 2; ++k) kp[64 * k] = pk2(v[k][0] * rstd * kvg[128 * k + 2 * lane], v[k][1] * rstd * kvg[128 * k + 2 * lane + 1]); }
        if (pos < 4096 && lane < 32) {
            const int g = lane >> 4, i = lane & 15; bf16_t* kr = KR + (size_t)m * 64 + 32 * g + i;
            const f32x2 cs = rope[(g ? (pos & 63) : (pos >> 6)) * 16 + i];
            const float t1 = bflo((unsigned)kr[0]), t2 = bflo((unsigned)kr[16]);
            kr[0] = (bf16_t)(pk2(t1 * cs.x - t2 * cs.y, 0.f) & 0xffffu); kr[16] = (bf16_t)(pk2(t2 * cs.x + t1 * cs.y, 0.f) & 0xffffu);
        }
    }
}

struct WJob { int in_idx, src_off, K, N, kind, pad; size_t dst; };
#define WJ_FFN(l) {8, (l) * DM * DFF, DM, DFF, 1, 0, WS_WGU(l)}, {9, (l) * DM * DFF, DM, DFF, 2, 0, WS_WGU(l)}, {10, (l) * DFF * DM, DFF, DM, 0, 0, WS_WD(l)}
__constant__ WJob kJobs[22] = {
    WJ_FFN(0), WJ_FFN(1), WJ_FFN(2), WJ_FFN(3),
    {11, 0, DM, 1536, 0, 0, WS_WA_QKV(0)}, {14, 0, DM, DM, 0, 0, WS_WA_O(0)}, {11, DM * 1536, DM, 1536, 0, 0, WS_WA_QKV(1)}, {14, DM * DM, DM, DM, 0, 0, WS_WA_O(1)},
    {15, 0, DM, 3072, 0, 0, WS_WB_QKV}, {17, 0, DM, DM, 0, 0, WS_WB_O},
    {18, 0, DM, 704, 0, 0, WS_WC_DQKV}, {21, 0, 384, 1536, 0, 0, WS_WC_UQ}, {22, 0, 256, 2048, 0, 0, WS_WC_UKV}, {23, 0, DM, DM, 0, 0, WS_WC_O}};
constexpr int NMOD_ITEMS = DEPTH * (MODW / 64);

DI void prologue_a(kaptr p, LAS unsigned char* lds) {
    const int tid = tidx(), lane = tid & 63, w = tid >> 6;
    int ntile_total = 0;
    for (int j = 0; j < 22; ++j) ntile_total += (kJobs[j].K / 64) * (kJobs[j].N / 64);
    const int nitems = NMOD_ITEMS + ntile_total;
    bool cond_ready = false;
    LAS float* cond = (LAS float*)(lds);
    LAS float* red = (LAS float*)(lds + 20480);
    LAS float* scr = (LAS float*)(lds + 32768);
    for (int it = bidx(); it < nitems; it += gridDim.x) {
        if (it < NMOD_ITEMS) {
            if (!cond_ready) {
                for (int t = tid; t < 5 * DM; t += 512) { const float cv = t < 4 * DM ? KIN(p, 1)[t] : KIN(p, 3)[t - 4 * DM]; cond[t] = cv / (1.0f + __expf(-cv)); }
                cond_ready = true;
            }
            __syncthreads();
            const int layer = it / (MODW / 64), n0 = (it - layer * (MODW / 64)) * 64;
            const float* wp = KIN(p, 4) + (size_t)layer * DM * MODW + (size_t)(128 * w) * MODW + n0 + lane;
            float acc[5] = {0.f, 0.f, 0.f, 0.f, 0.f};
#pragma unroll 8
            for (int k = 0; k < 128; ++k) { const float wv = wp[(size_t)k * MODW];
#pragma unroll
                for (int rI = 0; rI < 5; ++rI) acc[rI] += cond[rI * DM + 128 * w + k] * wv; }
#pragma unroll
            for (int rI = 0; rI < 5; ++rI) red[(w * 5 + rI) * 64 + lane] = acc[rI];
            __syncthreads();
            if (tid < 320) { const int rI = tid >> 6; float s = KIN(p, 5)[(size_t)layer * MODW + n0 + lane];
#pragma unroll
                for (int ww = 0; ww < 8; ++ww) s += red[(ww * 5 + rI) * 64 + lane];
                ((float*)(KWS(p) + WS_MOD))[((size_t)layer * 5 + rI) * MODW + n0 + lane] = s; }
        } else {
            int t = it - NMOD_ITEMS, j = 0;
            for (; j < 21; ++j) { const int nt = (kJobs[j].K / 64) * (kJobs[j].N / 64); if (t < nt) break; t -= nt; }
            const WJob jb = kJobs[j];
            const int nblk = jb.N / 64, kb = t / nblk, nb = t - kb * nblk, k0 = 64 * kb, n0 = 64 * nb;
            const float* W = KIN(p, jb.in_idx) + jb.src_off;
            __syncthreads();
#pragma unroll
            for (int i = 0; i < 8; ++i) { const int kk = w + 8 * i; scr[lane * 65 + kk] = W[(size_t)(k0 + kk) * jb.N + n0 + lane]; }
            __syncthreads();
            const int n = tid >> 3, c = tid & 7; const LAS float* s = scr + n * 65 + 8 * c;
            u32x4 o; o.x = pk2(s[0], s[1]); o.y = pk2(s[2], s[3]); o.z = pk2(s[4], s[5]); o.w = pk2(s[6], s[7]);
            const int nn = n0 + n; const int drow = jb.kind == 0 ? nn : 256 * (nn >> 7) + (nn & 127) + (jb.kind == 2 ? 128 : 0);
            *(u32x4*)((bf16_t*)(KWS(p) + jb.dst) + (size_t)drow * jb.K + k0 + 8 * c) = o;
        }
    }
    const int gt = bidx() * 512 + tid, NGT = gridDim.x * 512;
    for (int t = gt; t < 64 * 32; t += NGT) { const int pos = t >> 5, i = t & 31; const float f = exp2f(-(float)(2 * i) * (1.0f / 64.0f) * 13.287712379549449f); float sn, cs; sincosf((float)pos * f, &sn, &cs); ((f32x2*)(KWS(p) + WS_ROPEA))[t] = (f32x2){cs, sn}; }
    for (int t = gt; t < 64 * 16; t += NGT) { const int pos = t >> 4, i = t & 15; const float f = exp2f(-(float)(2 * i) * (1.0f / 32.0f) * 13.287712379549449f); float sn, cs; sincosf((float)pos * f, &sn, &cs); ((f32x2*)(KWS(p) + WS_ROPEC))[t] = (f32x2){cs, sn}; }
    for (int t = gt; t < 64 * DM / 8; t += NGT) ((u32x4*)((bf16_t*)(KWS(p) + WS_WC_DQKV) + (size_t)704 * DM))[t] = (u32x4){0u, 0u, 0u, 0u};
    __syncthreads();
}

constexpr int NPHASES = 2 + 9 * DEPTH;
#define PHASE_BEGIN(k) if (lo <= (k) && (k) < hi) { kaptr p = (kaptr)__builtin_amdgcn_kernarg_segment_ptr(); asm volatile("" : "+s"(p)); unsigned char* ws = KWS(p); (void)ws;
#define PHASE_END(k) if ((k) + 1 < hi) grid.sync(); }
template <int LAYER> DI void layer_phases(int lo, int hi, LAS unsigned char* lds, cg::grid_group& grid) {
    constexpr int kind = LAYER % 3, inst = LAYER / 3, P0 = 2 + 9 * LAYER;
    constexpr size_t MODL = WS_MOD + (size_t)LAYER * 5 * MODW * 4;
    PHASE_BEGIN(P0 + 0)
        bf16_t* H = (bf16_t*)(ws + WS_H);
        if constexpr (kind == 0) { const EpiStore E = EpiStore::make((bf16_t*)(ws + WS_AQ), (bf16_t*)(ws + WS_AK), (bf16_t*)(ws + WS_AV), 1024, 1280, 1024, 256, 256, 1536);
            run_gemm(lds, H, (const bf16_t*)(ws + WS_WA_QKV(inst)), MROWS, 1536, DM, E); }
        else if constexpr (kind == 1) { const EpiStore E = EpiStore::make((bf16_t*)(ws + WS_BQ), (bf16_t*)(ws + WS_BK), (bf16_t*)(ws + WS_BV), 1024, 2048, 1024, 1024, 1024, 3072);
            run_gemm(lds, H, (const bf16_t*)(ws + WS_WB_QKV), MROWS, 3072, DM, E); }
        else { const EpiStore E = EpiStore::make((bf16_t*)(ws + WS_CQL), (bf16_t*)(ws + WS_CKVL), (bf16_t*)(ws + WS_CKR), 384, 640, 384, 256, 64, 704);
            run_gemm(lds, H, (const bf16_t*)(ws + WS_WC_DQKV), MROWS, 768, DM, E); }
    PHASE_END(P0 + 0)
    if constexpr (kind == 0) { PHASE_BEGIN(P0 + 1) kpost_a(p, KIN(p, 13) + inst * 128); PHASE_END(P0 + 1) }
    if constexpr (kind == 2) {
        PHASE_BEGIN(P0 + 1) post_c(p, KIN(p, 19), KIN(p, 20)); PHASE_END(P0 + 1)
        PHASE_BEGIN(P0 + 2)
            { const EpiStore E = EpiStore::make((bf16_t*)(ws + WS_CQ), (bf16_t*)(ws + WS_CQ), (bf16_t*)(ws + WS_CQ), 0, 0, 1536, 1536, 1536, 1536);
              run_gemm(lds, (const bf16_t*)(ws + WS_CQL), (const bf16_t*)(ws + WS_WC_UQ), MROWS, 1536, 384, E); }
            { const EpiStore E = EpiStore::make((bf16_t*)(ws + WS_CKV), (bf16_t*)(ws + WS_CKV), (bf16_t*)(ws + WS_CKV), 0, 0, 2048, 2048, 2048, 2048);
              run_gemm(lds, (const bf16_t*)(ws + WS_CKVL), (const bf16_t*)(ws + WS_WC_UKV), MROWS, 2048, 256, E); }
        PHASE_END(P0 + 2)
    }
    PHASE_BEGIN(P0 + 3)
        bf16_t* H = (bf16_t*)(ws + WS_H);
        if constexpr (kind == 0) { const AttnArgs a{(const bf16_t*)(ws + WS_AQ), (const bf16_t*)(ws + WS_AK), (const bf16_t*)(ws + WS_AV), nullptr, H, KIN(p, 12) + inst * 128, nullptr, (const f32x2*)(ws + WS_ROPEA)}; attn_phase<0>(lds, a); }
        else if constexpr (kind == 1) { const AttnArgs a{(const bf16_t*)(ws + WS_BQ), (const bf16_t*)(ws + WS_BK), (const bf16_t*)(ws + WS_BV), nullptr, H, nullptr, KIN(p, 16), nullptr}; attn_phase<1>(lds, a); }
        else { const AttnArgs a{(const bf16_t*)(ws + WS_CQ), (const bf16_t*)(ws + WS_CKV), (const bf16_t*)(ws + WS_CKV), (const bf16_t*)(ws + WS_CKR), H, nullptr, nullptr, (const f32x2*)(ws + WS_ROPEC)}; attn_phase<2>(lds, a); }
    PHASE_END(P0 + 3)
    PHASE_BEGIN(P0 + 4)
        constexpr size_t WO = kind == 0 ? WS_WA_O(inst) : (kind == 1 ? WS_WB_O : WS_WC_O);
        const EpiResid E{KOUT(p), (float*)(ws + WS_XC), (const float*)(ws + MODL) + 2 * DM};
        run_gemm(lds, (const bf16_t*)(ws + WS_H), (const bf16_t*)(ws + WO), MROWS, DM, DM, E);
    PHASE_END(P0 + 4)
    PHASE_BEGIN(P0 + 5) rows_phase<true>(p, KIN(p, 6) + (size_t)(LAYER * 2 + 0) * DM, KIN(p, 7) + (size_t)(LAYER * 2 + 0) * DM, (const float*)(ws + MODL) + 3 * DM, true); PHASE_END(P0 + 5)
    PHASE_BEGIN(P0 + 6) const EpiSwiGLU E{(bf16_t*)(ws + WS_ACT)}; run_gemm(lds, (const bf16_t*)(ws + WS_H), (const bf16_t*)(ws + WS_WGU(LAYER)), MROWS, 2 * DFF, DM, E); PHASE_END(P0 + 6)
    PHASE_BEGIN(P0 + 7) const EpiResid E{KOUT(p), (float*)(ws + WS_XC), (const float*)(ws + MODL) + 5 * DM}; run_gemm(lds, (const bf16_t*)(ws + WS_ACT), (const bf16_t*)(ws + WS_WD(LAYER)), MROWS, DM, DFF, E); PHASE_END(P0 + 7)
    PHASE_BEGIN(P0 + 8) constexpr bool last = LAYER == DEPTH - 1;
        rows_phase<true>(p, KIN(p, 6) + (size_t)(LAYER * 2 + 1) * DM, KIN(p, 7) + (size_t)(LAYER * 2 + 1) * DM, (const float*)(ws + MODL) + (last ? 0 : 5 * MODW), !last); PHASE_END(P0 + 8)
}
static bool phase_exists(int ph) {
    if (ph < 2) return true;
    const int layer = (ph - 2) / 9, step = (ph - 2) - layer * 9, kind = layer % 3;
    if (step == 1) return kind != 1;
    if (step == 2) return kind == 2;
    return true;
}

__global__ void __launch_bounds__(512, 2) mk_fwd(Params prm) {
    extern __shared__ __attribute__((aligned(16))) unsigned char lds_raw[];
    LAS unsigned char* lds = (LAS unsigned char*)lds_raw;
    cg::grid_group grid = cg::this_grid();
    const int lo = prm.ph_lo, hi = prm.ph_hi;
    PHASE_BEGIN(0) prologue_a(p, lds); PHASE_END(0)
    PHASE_BEGIN(1) rows_phase<false>(p, nullptr, nullptr, (const float*)(ws + WS_MOD), true); PHASE_END(1)
    layer_phases<0>(lo, hi, lds, grid);
    layer_phases<1>(lo, hi, lds, grid);
    layer_phases<2>(lo, hi, lds, grid);
    layer_phases<3>(lo, hi, lds, grid);
}

#ifndef MK_MULTI
#define MK_MULTI 0
#endif
extern "C" void kernel_launch(void* const* d_in, const int* in_sizes, int n_in, void* d_out, int out_size, void* d_ws, size_t ws_size, hipStream_t stream) {
    static int grid = 0;
    if (grid == 0) {
        if (n_in != 24 || out_size != NBATCH * SEQ * DM || ws_size < WS_END) { fprintf(stderr, "kernel_launch: unexpected shapes (n_in %d, out %d, ws %zu < %zu)\n", n_in, out_size, ws_size, (size_t)WS_END); grid = -1; return; }
        int dev = 0, cus = 0, per_cu = 0;
        hipGetDevice(&dev); hipDeviceGetAttribute(&cus, hipDeviceAttributeMultiprocessorCount, dev);
        if (hipFuncSetAttribute((const void*)mk_fwd, hipFuncAttributeMaxDynamicSharedMemorySize, LDS_BYTES) != hipSuccess) { fprintf(stderr, "kernel_launch: hipFuncSetAttribute failed\n"); grid = -1; return; }
        if (hipOccupancyMaxActiveBlocksPerMultiprocessor(&per_cu, (const void*)mk_fwd, 512, LDS_BYTES) != hipSuccess || per_cu < 1) { fprintf(stderr, "kernel_launch: occupancy query says %d\n", per_cu); per_cu = 1; }
        (void)hipGetLastError();
        grid = cus * per_cu;
    }
    if (grid < 0) return;
    Params p{};
    for (int i = 0; i < 24; ++i) p.in[i] = (const float*)d_in[i];
    p.out = (float*)d_out; p.ws = (unsigned char*)d_ws;
#if MK_MULTI
    for (int ph = 0; ph < NPHASES; ++ph) {
        if (!phase_exists(ph)) continue;
        p.ph_lo = ph; p.ph_hi = ph + 1;
        hipLaunchKernelGGL(mk_fwd, dim3(grid), dim3(512), LDS_BYTES, stream, p);
    }
#else
    p.ph_lo = 0; p.ph_hi = NPHASES;
    void* args[] = {&p};
    hipError_t e = hipLaunchCooperativeKernel((const void*)mk_fwd, dim3(grid), dim3(512), args, LDS_BYTES, stream);
    if (e != hipSuccess) fprintf(stderr, "cooperative launch failed: %s (grid %d)\n", hipGetErrorString(e), grid);
#endif
}
```

```cpp
#include <hip/hip_runtime.h>
#include <hip/hip_cooperative_groups.h>
#include <cstdio>
#include <cstdint>
namespace cg = cooperative_groups;
__device__ __forceinline__ int tidx(int wv) { int t = wv * 64 + (int)__builtin_amdgcn_mbcnt_hi(~0u, __builtin_amdgcn_mbcnt_lo(~0u, 0u)); asm volatile("" : "+v"(t)); return t; }
__device__ __forceinline__ int bidx() { int b = blockIdx.x; asm volatile("" : "+s"(b)); return b; }
namespace pg8 {
#define PG8_LAS __attribute__((address_space(3)))
typedef unsigned short bf16_t;
typedef short bf16x8 __attribute__((ext_vector_type(8)));
typedef float f32x4 __attribute__((ext_vector_type(4)));
typedef unsigned u32x4 __attribute__((ext_vector_type(4)));
constexpr int BM = 256, BK = 64, HALF = 128, HTB = HALF * BK * 2  , STAGE_BYTES = 8 * HTB, NXCD = 8, WGM = 8;

__host__ __device__ __forceinline__ int lds_byte(int r, int c) { const int st = (r >> 4) * 2 + (c >> 5), rr = r & 15, cc = c & 31, ob = rr * 64 + cc * 2; return st * 1024 + (ob ^ (((ob >> 9) & 1) << 5)); }
__host__ __device__ __forceinline__ void stage_rc(int b, int& R, int& C) { const int st = b / 1024, sb = b % 1024, swz = sb ^ (((sb >> 9) & 1) << 5); R = (st >> 1) * 16 + swz / 64; C = (st & 1) * 32 + (swz % 64) / 2; }
__host__ __device__ __forceinline__ int perm32(int rho) { const int n = rho >> 4, i = rho & 15; return 8 * (i >> 2) + 4 * n + (i & 3); }

struct Unit { int pm, pn, k0, nt, ks; };
struct Gemm { const bf16_t* A; const bf16_t* Bt; int M, N, K; };

struct StaticOrder {
    int nM, nN, nwg, G, c, ntk;
    __host__ __device__ void init(int M, int N, int G_, int c_) { nM = M / BM; nN = N / BM; nwg = nM * nN; G = G_; c = c_; }
    __host__ __device__ bool next(int i, Unit& u) const {
        const long L = (long)i * G + c; if (L >= nwg) return false;
        int wgid = (int)L; { const int q = nwg / NXCD, r = nwg % NXCD, xcd = wgid % NXCD, off = wgid / NXCD; wgid = (xcd < r ? xcd * (q + 1) : r * (q + 1) + (xcd - r) * q) + off; }
        const int nig = WGM * nN, gid = wgid / nig, fm = gid * WGM, gsz = (nM - fm) < WGM ? (nM - fm) : WGM;
        u.pm = fm + ((wgid % nig) % gsz); u.pn = (wgid % nig) / gsz; u.k0 = 0; u.nt = ntk; u.ks = -1; return true;
    }
    __device__ __forceinline__ void a_ready(const Unit&) const {}
    __device__ __forceinline__ void done(const Unit&) const {}
};
template <class Epi, class Sched, bool ALIGN_EPI = false, bool SP2 = false>
__device__ __forceinline__ void gemm_phase(PG8_LAS unsigned char* lds, const Gemm g, const Sched& S, const Epi& E, int wv) {
    const int tid = tidx(wv), wid = __builtin_amdgcn_readfirstlane(tid >> 6), lane = tid & 63, wr = wid >> 2, wc = wid & 3, fr = lane & 15, fq = lane >> 4;
    const int K = g.K;
    unsigned voffA[2], voffB[2];
#pragma unroll
    for (int i = 0; i < 2; ++i) { int R, C; stage_rc(tid * 16 + i * 8192, R, C); const int Rb = Epi::PERM ? ((R & ~31) + perm32(R & 31)) : R;
        voffA[i] = (unsigned)(R * K + C) * 2u; voffB[i] = (unsigned)(Rb * K + C) * 2u; }
    const size_t kstep = (size_t)(BK * 2);
    const size_t hstep = (size_t)HALF * K * 2;
    const size_t tstep = 2 * hstep;
    const unsigned ldsw = (unsigned)wid * 1024u;
    const int aoff = lds_byte(wr * 64 + fr, fq * 8), boff = lds_byte(wc * 32 + fr, fq * 8);
#define PG8_SA(b, h) (((b) * 2 + (h)) * HTB)
#define PG8_SB(b, h) ((4 + (b) * 2 + (h)) * HTB)
#define PG8_STAGE(bufoff, gbase, voff) do { _Pragma("unroll") for (int _i = 0; _i < 2; ++_i) \
        __builtin_amdgcn_global_load_lds((const unsigned*)((const char*)(gbase) + (voff)[_i]), (PG8_LAS unsigned*)(lds + (bufoff) + ldsw + _i * 8192), 16, 0, 0); } while (0)
#define PG8_LDA(dst, b, h) do { _Pragma("unroll") for (int m = 0; m < 4; ++m) _Pragma("unroll") for (int k = 0; k < 2; ++k) dst[m][k] = *(const PG8_LAS bf16x8*)(lds + PG8_SA(b, h) + aoff + m * 2048 + k * 1024); } while (0)
#define PG8_LDB(dst, b, h) do { _Pragma("unroll") for (int n = 0; n < 2; ++n) _Pragma("unroll") for (int k = 0; k < 2; ++k) dst[n][k] = *(const PG8_LAS bf16x8*)(lds + PG8_SB(b, h) + boff + n * 2048 + k * 1024); } while (0)
#define PG8_MMA(ai, bj, At, Bt) do { __builtin_amdgcn_s_setprio(1); _Pragma("unroll") for (int m = 0; m < 4; ++m) _Pragma("unroll") for (int n = 0; n < 2; ++n) _Pragma("unroll") for (int k = 0; k < 2; ++k) \
        acc[ai][bj][m][n] = __builtin_amdgcn_mfma_f32_16x16x32_bf16(Bt[n][k], At[m][k], acc[ai][bj][m][n], 0, 0, 0); __builtin_amdgcn_s_setprio(0); } while (0)
#define PG8_WAIT_V(n) asm volatile("s_waitcnt vmcnt(" #n ")" ::: "memory")
#define PG8_WAIT_L(n) asm volatile("s_waitcnt lgkmcnt(" #n ")" ::: "memory")
#define PG8_BAR __builtin_amdgcn_s_barrier()
#define PG8_SCHED __builtin_amdgcn_sched_barrier(0)
    Unit cur, nxt; int ui = 0;
    if (!S.next(0, cur)) return;
    f32x4 acc[2][2][4][2];
#pragma unroll
    for (int a = 0; a < 2; ++a)
#pragma unroll
        for (int b = 0; b < 2; ++b)
#pragma unroll
            for (int m = 0; m < 4; ++m)
#pragma unroll
                for (int n = 0; n < 2; ++n) acc[a][b][m][n] = (f32x4){0.f, 0.f, 0.f, 0.f};
    bf16x8 At[4][2], B0[2][2], B1[2][2];
    const char* cA = (const char*)g.A + (size_t)cur.pm * tstep + (size_t)cur.k0 * 2; const char* cB = (const char*)g.Bt + (size_t)cur.pn * tstep + (size_t)cur.k0 * 2;
    int nt = cur.nt;
    S.a_ready(cur);
    if constexpr (SP2) {
        PG8_STAGE(PG8_SB(0, 0), cB, voffB); PG8_STAGE(PG8_SB(0, 1), cB + hstep, voffB); PG8_STAGE(PG8_SA(0, 0), cA, voffA); PG8_STAGE(PG8_SA(0, 1), cA + hstep, voffA);
        if (wr == 1) PG8_BAR;
        PG8_WAIT_V(2); PG8_BAR;
        PG8_STAGE(PG8_SB(1, 0), cB + kstep, voffB); PG8_STAGE(PG8_SA(1, 0), cA + kstep, voffA); PG8_STAGE(PG8_SB(1, 1), cB + hstep + kstep, voffB);
        PG8_WAIT_V(6); PG8_BAR;
    } else {
        PG8_STAGE(PG8_SB(0, 0), cB, voffB); PG8_STAGE(PG8_SA(0, 0), cA, voffA); PG8_STAGE(PG8_SB(0, 1), cB + hstep, voffB); PG8_STAGE(PG8_SA(0, 1), cA + hstep, voffA);
        if (wr == 1) PG8_BAR;
        PG8_WAIT_V(4); PG8_BAR;
        PG8_STAGE(PG8_SB(1, 0), cB + kstep, voffB); PG8_STAGE(PG8_SA(1, 0), cA + kstep, voffA); PG8_STAGE(PG8_SB(1, 1), cB + hstep + kstep, voffB);
        PG8_WAIT_V(6); PG8_BAR;
    }
    for (;;) {
        const bool has_next = S.next(ui + 1, nxt);
        const char* nA = has_next ? (const char*)g.A + (size_t)nxt.pm * tstep + (size_t)nxt.k0 * 2 : cA; const char* nB = has_next ? (const char*)g.Bt + (size_t)nxt.pn * tstep + (size_t)nxt.k0 * 2 : cB;
        for (int t = 0; t < nt; t += 2) {
            const bool last = (t == nt - 2);
            const char* a1 = cA + (size_t)(t + 1) * kstep;
            const char* a2 = last ? nA : cA + (size_t)(t + 2) * kstep; const char* b2 = last ? nB : cB + (size_t)(t + 2) * kstep;
            const char* a3 = a2 + kstep; const char* b3 = b2 + kstep;
            if (last && has_next) S.a_ready(nxt);
            if constexpr (SP2) {
            PG8_LDB(B0, 0, 0); PG8_LDB(B1, 0, 1); PG8_SCHED; PG8_LDA(At, 0, 0); PG8_STAGE(PG8_SA(1, 1), a1 + hstep, voffA);
            PG8_WAIT_V(8); PG8_WAIT_L(0); PG8_BAR; PG8_MMA(0, 0, At, B0); PG8_MMA(0, 1, At, B1); PG8_BAR; PG8_SCHED;
            PG8_LDA(At, 0, 1); PG8_STAGE(PG8_SB(0, 0), b2, voffB); PG8_STAGE(PG8_SB(0, 1), b2 + hstep, voffB); PG8_STAGE(PG8_SA(0, 0), a2, voffA);
            PG8_WAIT_V(8); PG8_WAIT_L(0); PG8_BAR; PG8_MMA(1, 0, At, B0); PG8_MMA(1, 1, At, B1); PG8_BAR; PG8_SCHED;
            PG8_LDB(B0, 1, 0); PG8_LDB(B1, 1, 1); PG8_SCHED; PG8_LDA(At, 1, 0); PG8_STAGE(PG8_SA(0, 1), a2 + hstep, voffA);
            PG8_WAIT_V(8); PG8_WAIT_L(0); PG8_BAR; PG8_MMA(0, 0, At, B0); PG8_MMA(0, 1, At, B1); PG8_BAR; PG8_SCHED;
            PG8_LDA(At, 1, 1); PG8_STAGE(PG8_SB(1, 0), b3, voffB); PG8_STAGE(PG8_SB(1, 1), b3 + hstep, voffB); PG8_STAGE(PG8_SA(1, 0), a3, voffA);
            PG8_WAIT_V(8); PG8_WAIT_L(0); PG8_BAR; PG8_MMA(1, 0, At, B0); PG8_MMA(1, 1, At, B1); PG8_BAR; PG8_SCHED;
            } else {
            PG8_LDB(B0, 0, 0); PG8_SCHED; PG8_LDA(At, 0, 0); PG8_STAGE(PG8_SA(1, 1), a1 + hstep, voffA);
            PG8_WAIT_L(8); PG8_BAR; PG8_WAIT_L(0); PG8_MMA(0, 0, At, B0); PG8_BAR; PG8_SCHED;
            PG8_LDB(B1, 0, 1); PG8_STAGE(PG8_SB(0, 0), b2, voffB);
            PG8_BAR; PG8_WAIT_L(0); PG8_MMA(0, 1, At, B1); PG8_BAR;
            PG8_LDA(At, 0, 1); PG8_STAGE(PG8_SA(0, 0), a2, voffA);
            PG8_BAR; PG8_WAIT_L(0); PG8_MMA(1, 0, At, B0); PG8_BAR; PG8_SCHED;
            PG8_STAGE(PG8_SB(0, 1), b2 + hstep, voffB);
            PG8_WAIT_V(6); PG8_BAR; PG8_MMA(1, 1, At, B1); PG8_BAR;
            PG8_LDB(B0, 1, 0); PG8_SCHED; PG8_LDA(At, 1, 0); PG8_STAGE(PG8_SA(0, 1), a2 + hstep, voffA);
            PG8_WAIT_L(8); PG8_BAR; PG8_WAIT_L(0); PG8_MMA(0, 0, At, B0); PG8_BAR; PG8_SCHED;
            PG8_LDB(B1, 1, 1); PG8_STAGE(PG8_SB(1, 0), b3, voffB);
            PG8_BAR; PG8_WAIT_L(0); PG8_MMA(0, 1, At, B1); PG8_BAR;
            PG8_LDA(At, 1, 1); PG8_STAGE(PG8_SA(1, 0), a3, voffA);
            PG8_BAR; PG8_WAIT_L(0); PG8_MMA(1, 0, At, B0); PG8_BAR; PG8_SCHED;
            PG8_STAGE(PG8_SB(1, 1), b3 + hstep, voffB);
            PG8_WAIT_V(6); PG8_BAR; PG8_MMA(1, 1, At, B1); PG8_BAR;
            }
        }
        if constexpr (ALIGN_EPI) { if (wr == 0) PG8_BAR; }
        if constexpr (!Epi::AFTER_DRAIN) { E(acc, cur, wr, wc, fr, fq); S.done(cur); }
        if (!has_next) break;
#pragma unroll
        for (int a = 0; a < 2; ++a)
#pragma unroll
            for (int b = 0; b < 2; ++b)
#pragma unroll
                for (int m = 0; m < 4; ++m)
#pragma unroll
                    for (int n = 0; n < 2; ++n) acc[a][b][m][n] = (f32x4){0.f, 0.f, 0.f, 0.f};
        cur = nxt; cA = nA; cB = nB; ++ui; nt = cur.nt;
        if constexpr (ALIGN_EPI) { if (wr == 1) PG8_BAR; }
    }
    PG8_WAIT_V(0);
    if constexpr (!ALIGN_EPI) { if (wr == 0) PG8_BAR; }
    PG8_BAR;
    if constexpr (Epi::AFTER_DRAIN) { E.fused(acc, cur, wr, wc, fr, fq, lds, wid, lane); S.done(cur); }
#undef PG8_SA
#undef PG8_SB
#undef PG8_STAGE
#undef PG8_LDA
#undef PG8_LDB
#undef PG8_MMA
#undef PG8_WAIT_V
#undef PG8_WAIT_L
#undef PG8_BAR
#undef PG8_SCHED
}
}

#define LAS __attribute__((address_space(3)))
#define DI __device__ __forceinline__
using pg8::bf16_t; using pg8::bf16x8; using pg8::f32x4; using pg8::u32x4;
typedef short s16x4 __attribute__((ext_vector_type(4)));
typedef float f32x16 __attribute__((ext_vector_type(16)));
typedef float f32x2 __attribute__((ext_vector_type(2)));
typedef unsigned u32x2 __attribute__((ext_vector_type(2)));
typedef __bf16 bf16x2_t __attribute__((ext_vector_type(2)));

constexpr int NBATCH = 4, SEQ = 4096, CTXL = 256, TPB = 4352, MROWS = NBATCH * TPB, DM = 1024, DFF = 2816, DEPTH = 4, MODW = 6 * DM;
constexpr float ALPHA = 1.6817928305074290f, LOG2E = 1.4426950408889634f;
constexpr size_t MiB = 1048576;
constexpr size_t WS_MOD = 0, WS_ROPEA = 512 * 1024, WS_ROPEC = WS_ROPEA + 16384, WS_BAR = WS_ROPEC + 8192  , WS_XC = 1 * MiB, WS_H = 5 * MiB, WS_W = 39 * MiB;
constexpr size_t WS_WGU(int l) { return WS_W + (size_t)l * (33 * MiB / 2); }
constexpr size_t WS_WD(int l) { return WS_WGU(l) + 11 * MiB; }
constexpr size_t WS_WA_QKV(int j) { return WS_W + 66 * MiB + (size_t)j * 5 * MiB; }
constexpr size_t WS_WA_O(int j) { return WS_WA_QKV(j) + 3 * MiB; }
constexpr size_t WS_WB_QKV = WS_W + 76 * MiB, WS_WB_O = WS_WB_QKV + 6 * MiB;
constexpr size_t WS_WC_DQKV = WS_W + 84 * MiB, WS_WC_UQ = WS_WC_DQKV + 3 * MiB / 2, WS_WC_UKV = WS_WC_UQ + 9 * MiB / 8, WS_WC_O = WS_WC_UKV + 1 * MiB;
constexpr size_t WS_R = 129 * MiB;
constexpr size_t WS_AQ = WS_R, WS_AK = WS_R + 34 * MiB, WS_AV = WS_AK + 17 * MiB / 2;
constexpr size_t WS_BQ = WS_R, WS_BK = WS_R + 34 * MiB, WS_BV = WS_R + 68 * MiB;
constexpr size_t WS_CQ = WS_R, WS_CKV = WS_R + 51 * MiB, WS_CKR = WS_R + 119 * MiB, WS_CQL = WS_R + 122 * MiB, WS_CKVL = WS_R + 135 * MiB;
constexpr size_t WS_ACT = WS_R, WS_PART = WS_R + 96 * MiB  ;
constexpr size_t WS_END = WS_R + 144 * MiB;
static_assert(WS_WC_O + 2 * MiB <= WS_R, "weights fit");

constexpr int LDS_BYTES = 147456;

struct Params { const float* in[24]; float* out; unsigned char* ws; int ph_lo, ph_hi; };
typedef const __attribute__((address_space(4))) unsigned char* kaptr;
DI const float* KIN(kaptr ka, int i) { return *(const float* const __attribute__((address_space(4)))*)(ka + 8 * i); }
DI float* KOUT(kaptr ka) { return *(float* const __attribute__((address_space(4)))*)(ka + 192); }
DI unsigned char* KWS(kaptr ka) { return *(unsigned char* const __attribute__((address_space(4)))*)(ka + 200); }

DI unsigned pk2(float lo, float hi) { f32x2 v = {lo, hi}; return __builtin_bit_cast(unsigned, __builtin_convertvector(v, bf16x2_t)); }
DI float bflo(unsigned u) { return __uint_as_float(u << 16); }
DI float bfhi(unsigned u) { return __uint_as_float(u & 0xffff0000u); }
DI void unpack8(const u32x4 w, float (&f)[8]) { f[0] = bflo(w.x); f[1] = bfhi(w.x); f[2] = bflo(w.y); f[3] = bfhi(w.y); f[4] = bflo(w.z); f[5] = bfhi(w.z); f[6] = bflo(w.w); f[7] = bfhi(w.w); }
DI u32x4 pack8(const float (&f)[8]) { u32x4 w; w.x = pk2(f[0], f[1]); w.y = pk2(f[2], f[3]); w.z = pk2(f[4], f[5]); w.w = pk2(f[6], f[7]); return w; }
DI float wave_sum(float v) {
#pragma unroll
    for (int o = 1; o < 64; o <<= 1) v += __shfl_xor(v, o);
    return v;
}
DI float silu_f(float x) { return x * __builtin_amdgcn_rcpf(1.0f + __expf(-x)); }

struct EpiStore {
    static constexpr bool PERM = true, AFTER_DRAIN = false;
    bf16_t* p2; long long d12, d01; int ld2, dl12, dl01, c1, c2, nvalid;
    static DI EpiStore make(bf16_t* p0, bf16_t* p1, bf16_t* p2, int c1, int c2, int ld0, int ld1, int ld2, int nvalid) {
        EpiStore e; e.p2 = p2; e.d12 = (long long)(p1 - p2); e.d01 = (long long)(p0 - p1); e.ld2 = ld2; e.dl12 = ld1 - ld2; e.dl01 = ld0 - ld1; e.c1 = c1; e.c2 = c2; e.nvalid = nvalid; return e; }
    DI void operator()(const f32x4 (&acc)[2][2][4][2], const pg8::Unit& u, int wr, int wc, int fr, int fq) const {
        const int row0 = u.pm * 256 + wr * 64 + fr;
#pragma unroll
        for (int bj = 0; bj < 2; ++bj) {
            const int col = u.pn * 256 + bj * 128 + wc * 32 + 8 * fq;
            const int m0 = -(int)(col < c1), m1 = -(int)(col < c2);
            bf16_t* base = p2 + ((d12 & (long long)m1) + (d01 & (long long)m0));
            const int ld = ld2 + (dl12 & m1) + (dl01 & m0), lc = col - c2 + ((c2 - c1) & m1) + (c1 & m0);
            if (col < nvalid) {
#pragma unroll
                for (int ai = 0; ai < 2; ++ai)
#pragma unroll
                    for (int m = 0; m < 4; ++m) {
                        const f32x4 v0 = acc[ai][bj][m][0], v1 = acc[ai][bj][m][1];
                        u32x4 w; w.x = pk2(v0[0], v0[1]); w.y = pk2(v0[2], v0[3]); w.z = pk2(v1[0], v1[1]); w.w = pk2(v1[2], v1[3]);
                        *(u32x4*)(base + (size_t)(row0 + ai * 128 + m * 16) * ld + lc) = w;
                    }
            }
        }
    }
};
struct EpiResid {
    static constexpr bool PERM = true, AFTER_DRAIN = false;
    float* xlat; float* xctx; const float* gate; float* part;
    DI void operator()(const f32x4 (&acc)[2][2][4][2], const pg8::Unit& u, int wr, int wc, int fr, int fq) const {
        const int b = u.pm / 17, t = u.pm - b * 17;
        const int rl = wr * 64 + fr;
        if (u.ks >= 0) {
            float* pb = part + ((size_t)u.ks * 1024 + (size_t)b * 256) * DM;
#pragma unroll
            for (int bj = 0; bj < 2; ++bj) {
                const int col = u.pn * 256 + bj * 128 + wc * 32 + 8 * fq;
#pragma unroll
                for (int ai = 0; ai < 2; ++ai)
#pragma unroll
                    for (int m = 0; m < 4; ++m) {
                        float* xp = pb + (size_t)(rl + ai * 128 + m * 16) * DM + col;
                        *(f32x4*)xp = acc[ai][bj][m][0]; *(f32x4*)(xp + 4) = acc[ai][bj][m][1];
                    }
            }
            return;
        }
        float* xb = (t == 16) ? xctx + (size_t)b * 256 * DM : xlat + ((size_t)b * 4096 + t * 256) * DM;
        const float* g = gate + (size_t)((t == 16) ? 4 : b) * MODW;
#pragma unroll
        for (int bj = 0; bj < 2; ++bj) {
            const int col = u.pn * 256 + bj * 128 + wc * 32 + 8 * fq;
            const f32x4 g0 = *(const f32x4*)(g + col), g1 = *(const f32x4*)(g + col + 4);
#pragma unroll
            for (int ai = 0; ai < 2; ++ai) {
#pragma unroll
                for (int m = 0; m < 4; ++m) {
                    float* xp = xb + (size_t)(rl + ai * 128 + m * 16) * DM + col;
                    const f32x4 x0 = *(const f32x4*)xp, x1 = *(const f32x4*)(xp + 4);
                    *(f32x4*)xp = x0 * ALPHA + g0 * acc[ai][bj][m][0];
                    *(f32x4*)(xp + 4) = x1 * ALPHA + g1 * acc[ai][bj][m][1];
                }
                asm volatile("" ::: "memory");
            }
        }
    }
};
struct EpiSwiGLU {
    static constexpr bool PERM = true, AFTER_DRAIN = false;
    bf16_t* act;
    DI void operator()(const f32x4 (&acc)[2][2][4][2], const pg8::Unit& u, int wr, int wc, int fr, int fq) const {
        const int row0 = u.pm * 256 + wr * 64 + fr, col = u.pn * 128 + wc * 32 + 8 * fq;
#pragma unroll
        for (int ai = 0; ai < 2; ++ai)
#pragma unroll
            for (int m = 0; m < 4; ++m) {
                const f32x4 a0 = acc[ai][0][m][0], a1 = acc[ai][0][m][1], b0 = acc[ai][1][m][0], b1 = acc[ai][1][m][1];
                u32x4 w;
                w.x = pk2(silu_f(a0[0]) * b0[0], silu_f(a0[1]) * b0[1]); w.y = pk2(silu_f(a0[2]) * b0[2], silu_f(a0[3]) * b0[3]);
                w.z = pk2(silu_f(a1[0]) * b1[0], silu_f(a1[1]) * b1[1]); w.w = pk2(silu_f(a1[2]) * b1[2], silu_f(a1[3]) * b1[3]);
                *(u32x4*)(act + (size_t)(row0 + ai * 128 + m * 16) * DFF + col) = w;
            }
    }
};
template <class Epi> DI void run_gemm(LAS unsigned char* lds, int wv, const bf16_t* A, const bf16_t* Bt, int M, int N, int K, const Epi& E) {
    pg8::Gemm g{A, Bt, M, N, K}; pg8::StaticOrder S; S.init(M, N, (int)gridDim.x, bidx()); S.ntk = K / 64;
    pg8::gemm_phase<Epi, pg8::StaticOrder, true, true>(lds, g, S, E, wv);
}
struct LatCtxOrder {
    pg8::StaticOrder so; int KS, nsplit, G, c;
    DI void init(int N, int K, int KS_, int G_, int c_) { so.init(NBATCH * SEQ, N, G_, c_); so.ntk = K / 64; KS = KS_; nsplit = 4 * (N / 256) * KS_; G = G_; c = c_; }
    DI bool next(int i, pg8::Unit& u) const {
        const int L = i * G + c;
        if (L < so.nwg) { so.next(i, u); u.pm += u.pm >> 4; return true; }
        const int s = L - so.nwg; if (s >= nsplit) return false;
        const int kp = s % KS, u16 = s / KS, nN = so.nN;
        u.pm = 17 * (u16 / nN) + 16; u.pn = u16 % nN; u.nt = so.ntk / KS; u.k0 = kp * u.nt * 64; u.ks = kp; return true;
    }
    DI void a_ready(const pg8::Unit&) const {}
    DI void done(const pg8::Unit&) const {}
};
template <class Epi> DI void run_gemm_lat(LAS unsigned char* lds, int wv, const bf16_t* A, const bf16_t* Bt, int N, int K, int KS, const Epi& E) {
    pg8::Gemm g{A, Bt, MROWS, N, K}; LatCtxOrder S; S.init(N, K, KS, (int)gridDim.x, bidx());
    pg8::gemm_phase<Epi, LatCtxOrder, true, true>(lds, g, S, E, wv);
}

struct AttnArgs { const bf16_t* Q; const bf16_t* K; const bf16_t* V; const bf16_t* K2; bf16_t* O; const float* gain; const float* rpb; const f32x2* rope; };
DI int crow(int i, int h) { return (i & 3) + 8 * (i >> 2) + 4 * h; }

template <int MODE> DI void attn_phase(LAS unsigned char* lds, const AttnArgs a, int wv, bool with_ctx) {
    constexpr int DK = MODE == 0 ? 128 : (MODE == 1 ? 64 : 192), DV = MODE == 1 ? 64 : 128;
    constexpr int KT = MODE == 0 ? 128 : (MODE == 1 ? 256 : 192), VT = MODE == 1 ? 256 : 128;
    constexpr int KSTR = KT * 2 + 16, VSTR = VT * 2 + 64, VOFF = 64 * KSTR, BOFF = VOFF + 64 * VSTR;
    constexpr int KCH = KT / 8, VCH = VT / 8, NKC = KT / 64, NVC = VT / 64, NS = DK / 16, NVB = DV / 32;
    constexpr int QLD = MODE == 2 ? 1536 : 1024;
    constexpr float QS = (MODE == 0 ? 0.08838834764831845f : (MODE == 1 ? 0.125f : 0.07216878364870322f)) * LOG2E;
    const int tid = tidx(wv), lane = tid & 63, w = __builtin_amdgcn_readfirstlane(tid >> 6), r = lane & 31, h = lane >> 5;
    const int nunits = MODE == 1 ? (with_ctx ? 1088 : 1024) : (with_ctx ? 544 : 512);
    const int kc0 = MODE == 1 ? 64 * (w >> 1) : 0;
    for (int u = bidx(); u < nunits; u += gridDim.x) {
        int b, head, hq = 0, qpos, nloc, base0, ntiles, rr = 0, rs = 0;
        if (MODE == 1) {
            if (u < 1024) { b = u >> 8; rr = (u >> 2) & 63; hq = u & 3; qpos = rr * 64 + 32 * (w & 1) + r; rs = min(max(rr - 4, 0), 56); nloc = 8; base0 = rs * 64; ntiles = 12; }
            else { const int v = u - 1024; b = v >> 4; hq = v & 3; qpos = 4096 + ((v >> 2) & 3) * 64 + 32 * (w & 1) + r; nloc = 0; base0 = 0; ntiles = 4; }
            head = 4 * hq + (w >> 1);
        } else {
            if (u < 512) { b = u >> 7; head = (u >> 4) & 7; qpos = (u & 15) * 256 + 32 * w + r; nloc = 68; base0 = 0; ntiles = 68; }
            else { const int v = u - 512; b = v >> 3; head = v & 7; qpos = 4096 + 32 * w + r; nloc = 0; base0 = 0; ntiles = 4; }
        }
        const int kvh = head >> 2;
        const size_t rowb = (size_t)b * TPB;
        const bool lat = qpos < 4096;
        bf16x8 qf[NS];
        {
            const bf16_t* qp = a.Q + (rowb + qpos) * QLD + head * DK + 8 * h;
            u32x4 qraw[NS];
#pragma unroll
            for (int s = 0; s < NS; ++s) qraw[s] = *(const u32x4*)(qp + 16 * s);
            if (MODE == 0) {
                float ss = 0.f;
#pragma unroll
                for (int s = 0; s < NS; ++s) { float f[8]; unpack8(qraw[s], f);
#pragma unroll
                    for (int e = 0; e < 8; ++e) ss += f[e] * f[e]; }
                ss += __shfl_xor(ss, 32);
                const float rstd = rsqrtf(ss * (1.0f / 128.0f) + 1e-6f) * QS;
                const int pr = qpos >> 6, pc = qpos & 63;
#pragma unroll
                for (int g = 0; g < 4; ++g) {
                    const int s0 = (g & 1) + 4 * (g >> 1), s1 = s0 + 2, pos = (g >> 1) ? pc : pr, i0 = 16 * (g & 1) + 8 * h;
                    float t1[8], t2[8], o1[8], o2[8]; unpack8(qraw[s0], t1); unpack8(qraw[s1], t2);
                    const float* g1 = a.gain + 16 * s0 + 8 * h; const float* g2 = a.gain + 16 * s1 + 8 * h;
#pragma unroll
                    for (int e = 0; e < 8; ++e) {
                        f32x2 cs = a.rope[pos * 32 + i0 + e]; if (!lat) { cs.x = 1.f; cs.y = 0.f; }
                        const float x1 = t1[e] * rstd * g1[e], x2 = t2[e] * rstd * g2[e];
                        o1[e] = x1 * cs.x - x2 * cs.y; o2[e] = x2 * cs.x + x1 * cs.y;
                    }
                    qraw[s0] = pack8(o1); qraw[s1] = pack8(o2);
                    asm volatile("" ::: "memory");
                }
            } else if (MODE == 1) {
#pragma unroll
                for (int s = 0; s < NS; ++s) { float f[8]; unpack8(qraw[s], f);
#pragma unroll
                    for (int e = 0; e < 8; ++e) f[e] *= QS;
                    qraw[s] = pack8(f); }
            } else {
#pragma unroll
                for (int s = 0; s < 8; ++s) { float f[8]; unpack8(qraw[s], f);
#pragma unroll
                    for (int e = 0; e < 8; ++e) f[e] *= QS;
                    qraw[s] = pack8(f); }
#ifndef EXP_NOROPE2
                const int pr = qpos >> 6, pc = qpos & 63;
#pragma unroll
                for (int g = 0; g < 2; ++g) {
                    const int s0 = 8 + 2 * g, s1 = s0 + 1, pos = g ? pc : pr;
                    float t1[8], t2[8], o1[8], o2[8]; unpack8(qraw[s0], t1); unpack8(qraw[s1], t2);
#pragma unroll
                    for (int e = 0; e < 8; ++e) {
                        f32x2 cs = a.rope[pos * 16 + 8 * h + e]; if (!lat) { cs.x = 1.f; cs.y = 0.f; }
                        const float x1 = t1[e] * QS, x2 = t2[e] * QS;
                        o1[e] = x1 * cs.x - x2 * cs.y; o2[e] = x2 * cs.x + x1 * cs.y;
                    }
                    qraw[s0] = pack8(o1); qraw[s1] = pack8(o2);
                    asm volatile("" ::: "memory");
                }
#endif
            }
#pragma unroll
            for (int s = 0; s < NS; ++s) qf[s] = __builtin_bit_cast(bf16x8, qraw[s]);
        }
        __syncthreads();
        if (MODE == 1 && nloc > 0) {
            LAS float* bl = (LAS float*)(lds + BOFF);
            for (int t = tid; t < 4 * 465; t += 512) bl[t] = a.rpb[(size_t)(4 * hq) * 465 + t] * LOG2E;
        }
        f32x16 oacc[NVB];
#pragma unroll
        for (int vb = 0; vb < NVB; ++vb)
#pragma unroll
            for (int i = 0; i < 16; ++i) oacc[vb][i] = 0.f;
        float mrun = -1e30f, lrun = 0.f;
        u32x4 kreg[NKC], vreg[NVC];
#define ATT_LOAD_TILE(kp) do { \
        _Pragma("unroll") for (int i_ = 0; i_ < NKC; ++i_) { const int ci = tl_ + 512 * i_, kr = ci / KCH, cc = ci - kr * KCH; const size_t row = rowb + (kp) + kr; const bf16_t* src; \
            if (MODE == 0) src = a.K + row * 256 + kvh * 128 + cc * 8; else if (MODE == 1) src = a.K + row * 1024 + hq * 256 + cc * 8; \
            else src = (cc < 16) ? a.K + row * 2048 + head * 256 + cc * 8 : a.K2 + row * 64 + (cc - 16) * 8; \
            kreg[i_] = *(const u32x4*)src; } \
        _Pragma("unroll") for (int i_ = 0; i_ < NVC; ++i_) { const int ci = tl_ + 512 * i_, kr = ci / VCH, cc = ci - kr * VCH; const size_t row = rowb + (kp) + kr; const bf16_t* src; \
            if (MODE == 0) src = a.V + row * 256 + kvh * 128 + cc * 8; else if (MODE == 1) src = a.V + row * 1024 + hq * 256 + cc * 8; \
            else src = a.V + row * 2048 + head * 256 + 128 + cc * 8; \
            vreg[i_] = *(const u32x4*)src; } } while (0)
        { int tl_ = tid; asm volatile("" : "+v"(tl_)); ATT_LOAD_TILE(nloc > 0 ? base0 : 4096); }
        for (int j = 0; j < ntiles; ++j) {
            int tl_ = tid; asm volatile("" : "+v"(tl_));
            const int ln_ = tl_ & 63, r = ln_ & 31, h = ln_ >> 5;
            __syncthreads();
#pragma unroll
            for (int i_ = 0; i_ < NKC; ++i_) { const int ci = tl_ + 512 * i_, kr = ci / KCH, cc = ci - kr * KCH; *(LAS u32x4*)(lds + kr * KSTR + cc * 16) = kreg[i_]; }
#pragma unroll
            for (int i_ = 0; i_ < NVC; ++i_) { const int ci = tl_ + 512 * i_, kr = ci / VCH, cc = ci - kr * VCH; *(LAS u32x4*)(lds + VOFF + kr * VSTR + cc * 16) = vreg[i_]; }
            __syncthreads();
            if (j + 1 < ntiles) { const int jn = j + 1; const int kpn = jn < nloc ? base0 + 64 * jn : 4096 + 64 * (jn - nloc); ATT_LOAD_TILE(kpn); }
            f32x16 sacc[2];
#pragma unroll
            for (int kb = 0; kb < 2; ++kb) {
#pragma unroll
                for (int i = 0; i < 16; ++i) sacc[kb][i] = 0.f;
#pragma unroll
                for (int s = 0; s < NS; ++s) {
                    const bf16x8 kf = *(const LAS bf16x8*)(lds + (32 * kb + r) * KSTR + (kc0 + 16 * s + 8 * h) * 2);
                    sacc[kb] = __builtin_amdgcn_mfma_f32_32x32x16_bf16(kf, qf[s], sacc[kb], 0, 0, 0);
                    if ((s & 3) == 3) asm volatile("" ::: "memory");
                }
            }
            if (MODE == 1 && j < nloc) {
                const int c = qpos & 63, cs = min(max(c - 8, 0), 48), dr = rs + j - rr + 7;
                const LAS float* bl = (const LAS float*)(lds + BOFF) + ((w >> 1) * 15 + dr) * 31 + 15 - c;
#pragma unroll
                for (int kb = 0; kb < 2; ++kb) {
#pragma unroll
                    for (int i = 0; i < 16; ++i) {
                        const int jc = 32 * kb + crow(i, h); const bool ok = (unsigned)(jc - cs) < 16u;
                        const float bias = bl[ok ? jc : c];
                        sacc[kb][i] = ok ? sacc[kb][i] + bias : -1e30f;
                        if ((i & 7) == 7) asm volatile("" ::: "memory");
                    }
                }
            }
            float mx = sacc[0][0];
#pragma unroll
            for (int kb = 0; kb < 2; ++kb)
#pragma unroll
                for (int i = 0; i < 16; ++i) mx = fmaxf(mx, sacc[kb][i]);
            mx = fmaxf(mx, __shfl_xor(mx, 32));
            const float mnew = fmaxf(mrun, mx), alpha = __builtin_amdgcn_exp2f(mrun - mnew);
            mrun = mnew;
            float sum = 0.f;
#pragma unroll
            for (int kb = 0; kb < 2; ++kb)
#pragma unroll
                for (int i = 0; i < 16; ++i) { const float p = __builtin_amdgcn_exp2f(sacc[kb][i] - mnew); sacc[kb][i] = p; sum += p; }
            asm volatile("" : "+v"(sum));
            lrun = lrun * alpha + sum;
#pragma unroll
            for (int vb = 0; vb < NVB; ++vb)
#pragma unroll
                for (int i = 0; i < 16; ++i) oacc[vb][i] *= alpha;
            bf16x8 pf[4];
#pragma unroll
            for (int t = 0; t < 4; ++t) {
                const int kb = t >> 1, o = 8 * (t & 1);
                u32x4 pw; pw.x = pk2(sacc[kb][o], sacc[kb][o + 1]); pw.y = pk2(sacc[kb][o + 2], sacc[kb][o + 3]); pw.z = pk2(sacc[kb][o + 4], sacc[kb][o + 5]); pw.w = pk2(sacc[kb][o + 6], sacc[kb][o + 7]);
                pf[t] = __builtin_bit_cast(bf16x8, pw);
            }
            {
                const int i16 = ln_ & 15, q4 = i16 >> 2, p4 = i16 & 3, g1 = (ln_ >> 4) & 1;
                LAS unsigned char* vbase = lds + VOFF + (4 * h + q4) * VSTR + (kc0 + 16 * g1) * 2 + 8 * p4;
#pragma unroll
                for (int vb = 0; vb < NVB; ++vb)
#pragma unroll
                    for (int t = 0; t < 4; ++t) {
                        const s16x4 lo = __builtin_amdgcn_ds_read_tr16_b64_v4i16((LAS s16x4*)(vbase + (16 * t) * VSTR + 64 * vb));
                        const s16x4 hi = __builtin_amdgcn_ds_read_tr16_b64_v4i16((LAS s16x4*)(vbase + (16 * t + 8) * VSTR + 64 * vb));
                        const bf16x8 va = __builtin_shufflevector(lo, hi, 0, 1, 2, 3, 4, 5, 6, 7);
                        oacc[vb] = __builtin_amdgcn_mfma_f32_32x32x16_bf16(va, pf[t], oacc[vb], 0, 0, 0);
                        if (t == 3) asm volatile("" ::: "memory");
                    }
            }
        }
#undef ATT_LOAD_TILE
        {
            lrun += __shfl_xor(lrun, 32);
            const float inv = 1.0f / lrun;
            bf16_t* op = a.O + (rowb + qpos) * 1024 + head * DV + 4 * h;
#pragma unroll
            for (int vb = 0; vb < NVB; ++vb)
#pragma unroll
                for (int g = 0; g < 4; ++g) {
                    u32x2 wv; wv.x = pk2(oacc[vb][4 * g] * inv, oacc[vb][4 * g + 1] * inv); wv.y = pk2(oacc[vb][4 * g + 2] * inv, oacc[vb][4 * g + 3] * inv);
                    *(u32x2*)(op + 32 * vb + 8 * g) = wv;
                }
        }
    }
    __syncthreads();
}

DI float* xrow_ptr(float* xlat, float* xctx, int m) { const int b = m / TPB, pos = m - b * TPB; return pos < 4096 ? xlat + ((size_t)b * 4096 + pos) * DM : xctx + ((size_t)b * 256 + (pos - 4096)) * DM; }
DI int modrow(int m) { const int b = m / TPB, pos = m - b * TPB; return pos < 4096 ? b : 4; }

template <bool LN> DI void rows_phase(kaptr p, int wv, const float* lng, const float* lnb, const float* modp, bool write_h, int ctx_ks = 0, const float* gate = nullptr) {
    const int lane = tidx(wv) & 63, gw = bidx() * 8 + (tidx(wv) >> 6), NGW = gridDim.x * 8;
    float* xlat = KOUT(p); float* xctx = (float*)(KWS(p) + WS_XC); bf16_t* H = (bf16_t*)(KWS(p) + WS_H);
    for (int m = gw; m < MROWS; m += NGW) {
        float* xr = xrow_ptr(xlat, xctx, m);
        const float* src = xr;
        if (!LN) { const int b = m / TPB, pos = m - b * TPB; src = pos < 4096 ? KIN(p, 0) + ((size_t)b * 4096 + pos) * DM : KIN(p, 2) + ((size_t)b * 256 + (pos - 4096)) * DM; }
        f32x4 v[4];
        if (LN && ctx_ks != 0) {
            const int b = m / TPB, pos = m - b * TPB;
            if (pos >= 4096) {
                if (ctx_ks < 0) continue;
                const float* pp = (const float*)(KWS(p) + WS_PART) + ((size_t)b * 256 + (pos - 4096)) * DM + 4 * lane;
                const float* gp = gate + (size_t)4 * MODW + 4 * lane;
#pragma unroll
                for (int j = 0; j < 4; ++j) {
                    f32x4 a = *(const f32x4*)(pp + 256 * j);
                    for (int ks = 1; ks < ctx_ks; ++ks) a += *(const f32x4*)(pp + (size_t)ks * 1024 * DM + 256 * j);
                    v[j] = *(const f32x4*)(src + 4 * lane + 256 * j) * ALPHA + *(const f32x4*)(gp + 256 * j) * a;
                }
            } else {
#pragma unroll
                for (int j = 0; j < 4; ++j) v[j] = *(const f32x4*)(src + 4 * lane + 256 * j);
            }
        } else {
#pragma unroll
            for (int j = 0; j < 4; ++j) v[j] = *(const f32x4*)(src + 4 * lane + 256 * j);
        }
        if (LN) {
            float s = 0.f;
#pragma unroll
            for (int j = 0; j < 4; ++j) s += (v[j].x + v[j].y) + (v[j].z + v[j].w);
            const float mean = wave_sum(s) * (1.0f / DM);
            float s2 = 0.f;
#pragma unroll
            for (int j = 0; j < 4; ++j) { v[j] = v[j] - mean; s2 += (v[j].x * v[j].x + v[j].y * v[j].y) + (v[j].z * v[j].z + v[j].w * v[j].w); }
            const float rstd = rsqrtf(wave_sum(s2) * (1.0f / DM) + 1e-5f);
#pragma unroll
            for (int j = 0; j < 4; ++j) { const f32x4 g = *(const f32x4*)(lng + 4 * lane + 256 * j), bb = *(const f32x4*)(lnb + 4 * lane + 256 * j); v[j] = v[j] * rstd * g + bb; }
        }
#pragma unroll
        for (int j = 0; j < 4; ++j) *(f32x4*)(xr + 4 * lane + 256 * j) = v[j];
        if (write_h) {
            const float* mp = modp + (size_t)modrow(m) * MODW;
#pragma unroll
            for (int j = 0; j < 4; ++j) {
                const f32x4 sh = *(const f32x4*)(mp + 4 * lane + 256 * j), sc = *(const f32x4*)(mp + DM + 4 * lane + 256 * j);
                const f32x4 hh = v[j] * (sc + 1.0f) + sh;
                u32x2 wv; wv.x = pk2(hh.x, hh.y); wv.y = pk2(hh.z, hh.w);
                *(u32x2*)(H + (size_t)m * DM + 4 * lane + 256 * j) = wv;
            }
        }
    }
}

DI void kpost_a(kaptr p, int wv, const float* kgain) {
    bf16_t* K = (bf16_t*)(KWS(p) + WS_AK); const f32x2* rope = (const f32x2*)(KWS(p) + WS_ROPEA);
    const int lane = tidx(wv) & 63, j16 = lane & 15, sub = lane >> 4, gw = bidx() * 8 + (tidx(wv) >> 6), NGW = gridDim.x * 8;
    for (int it = gw; it < MROWS * 2 / 4; it += NGW) {
        const int item = it * 4 + sub, m = item >> 1, kvh = item & 1;
        const int b = m / TPB, pos = m - b * TPB; const bool lat = pos < 4096;
        unsigned* kp = (unsigned*)(K + (size_t)m * 256 + kvh * 128) + j16;
        float v[4][2]; float ss = 0.f;
#pragma unroll
        for (int k = 0; k < 4; ++k) { const unsigned wv = kp[16 * k]; v[k][0] = bflo(wv); v[k][1] = bfhi(wv); ss += v[k][0] * v[k][0] + v[k][1] * v[k][1]; }
        ss += __shfl_xor(ss, 1); ss += __shfl_xor(ss, 2); ss += __shfl_xor(ss, 4); ss += __shfl_xor(ss, 8);
        const float rstd = rsqrtf(ss * (1.0f / 128.0f) + 1e-6f);
#pragma unroll
        for (int k = 0; k < 4; ++k) { v[k][0] *= rstd * kgain[32 * k + 2 * j16]; v[k][1] *= rstd * kgain[32 * k + 2 * j16 + 1]; }
        if (lat) {
            const int pr = pos >> 6, pc = pos & 63;
#pragma unroll
            for (int g = 0; g < 2; ++g)
#pragma unroll
                for (int e = 0; e < 2; ++e) {
                    const f32x2 cs = rope[(g ? pc : pr) * 32 + 2 * j16 + e];
                    const float t1 = v[2 * g][e], t2 = v[2 * g + 1][e];
                    v[2 * g][e] = t1 * cs.x - t2 * cs.y; v[2 * g + 1][e] = t2 * cs.x + t1 * cs.y;
                }
        }
#pragma unroll
        for (int k = 0; k < 4; ++k) kp[16 * k] = pk2(v[k][0], v[k][1]);
    }
}
DI void post_c(kaptr p, int wv, const float* qg, const float* kvg) {
    bf16_t* QL = (bf16_t*)(KWS(p) + WS_CQL); bf16_t* KVL = (bf16_t*)(KWS(p) + WS_CKVL); bf16_t* KR = (bf16_t*)(KWS(p) + WS_CKR); const f32x2* rope = (const f32x2*)(KWS(p) + WS_ROPEC);
    const int lane = tidx(wv) & 63, gw = bidx() * 8 + (tidx(wv) >> 6), NGW = gridDim.x * 8;
    for (int m = gw; m < MROWS; m += NGW) {
        const int b = m / TPB, pos = m - b * TPB;
        {   unsigned* qp = (unsigned*)(QL + (size_t)m * 384) + lane; float v[3][2]; float ss = 0.f;
#pragma unroll
            for (int k = 0; k < 3; ++k) { const unsigned wv = qp[64 * k]; v[k][0] = bflo(wv); v[k][1] = bfhi(wv); ss += v[k][0] * v[k][0] + v[k][1] * v[k][1]; }
            const float rstd = rsqrtf(wave_sum(ss) * (1.0f / 384.0f) + 1e-6f);
#pragma unroll
            for (int k = 0; k < 3; ++k) qp[64 * k] = pk2(v[k][0] * rstd * qg[128 * k + 2 * lane], v[k][1] * rstd * qg[128 * k + 2 * lane + 1]); }
        {   unsigned* kp = (unsigned*)(KVL + (size_t)m * 256) + lane; float v[2][2]; float ss = 0.f;
#pragma unroll
            for (int k = 0; k < 2; ++k) { const unsigned wv = kp[64 * k]; v[k][0] = bflo(wv); v[k][1] = bfhi(wv); ss += v[k][0] * v[k][0] + v[k][1] * v[k][1]; }
            const float rstd = rsqrtf(wave_sum(ss) * (1.0f / 256.0f) + 1e-6f);
#pragma unroll
            for (int k = 0; k < 2; ++k) kp[64 * k] = pk2(v[k][0] * rstd * kvg[128 * k + 2 * lane], v[k][1] * rstd * kvg[128 * k + 2 * lane + 1]); }
        if (pos < 4096 && lane < 32) {
            const int g = lane >> 4, i = lane & 15; bf16_t* kr = KR + (size_t)m * 64 + 32 * g + i;
            const f32x2 cs = rope[(g ? (pos & 63) : (pos >> 6)) * 16 + i];
            const float t1 = bflo((unsigned)kr[0]), t2 = bflo((unsigned)kr[16]);
            kr[0] = (bf16_t)(pk2(t1 * cs.x - t2 * cs.y, 0.f) & 0xffffu); kr[16] = (bf16_t)(pk2(t2 * cs.x + t1 * cs.y, 0.f) & 0xffffu);
        }
    }
}

struct WJob { int in_idx, src_off, K, N, kind, pad; size_t dst; };
#define WJ_FFN(l) {8, (l) * DM * DFF, DM, DFF, 1, 0, WS_WGU(l)}, {9, (l) * DM * DFF, DM, DFF, 2, 0, WS_WGU(l)}, {10, (l) * DFF * DM, DFF, DM, 0, 0, WS_WD(l)}
__constant__ WJob kJobs[22] = {
    WJ_FFN(0), WJ_FFN(1), WJ_FFN(2), WJ_FFN(3),
    {11, 0, DM, 1536, 0, 0, WS_WA_QKV(0)}, {14, 0, DM, DM, 0, 0, WS_WA_O(0)}, {11, DM * 1536, DM, 1536, 0, 0, WS_WA_QKV(1)}, {14, DM * DM, DM, DM, 0, 0, WS_WA_O(1)},
    {15, 0, DM, 3072, 0, 0, WS_WB_QKV}, {17, 0, DM, DM, 0, 0, WS_WB_O},
    {18, 0, DM, 704, 0, 0, WS_WC_DQKV}, {21, 0, 384, 1536, 0, 0, WS_WC_UQ}, {22, 0, 256, 2048, 0, 0, WS_WC_UKV}, {23, 0, DM, DM, 0, 0, WS_WC_O}};
constexpr int NMOD_ITEMS = DEPTH * (MODW / 64);

DI void prologue_a(kaptr p, LAS unsigned char* lds, int wv) {
    const int tid = tidx(wv), lane = tid & 63, w = tid >> 6;
    int ntile_total = 0;
    for (int j = 0; j < 22; ++j) ntile_total += (kJobs[j].K / 64) * (kJobs[j].N / 64);
    const int nitems = NMOD_ITEMS + ntile_total;
    bool cond_ready = false;
    LAS float* cond = (LAS float*)(lds);
    LAS float* red = (LAS float*)(lds + 20480);
    LAS float* scr = (LAS float*)(lds + 32768);
    for (int it = bidx(); it < nitems; it += gridDim.x) {
        if (it < NMOD_ITEMS) {
            if (!cond_ready) {
                for (int t = tid; t < 5 * DM; t += 512) { const float cv = t < 4 * DM ? KIN(p, 1)[t] : KIN(p, 3)[t - 4 * DM]; cond[t] = cv / (1.0f + __expf(-cv)); }
                cond_ready = true;
            }
            __syncthreads();
            const int layer = it / (MODW / 64), n0 = (it - layer * (MODW / 64)) * 64;
            const float* wp = KIN(p, 4) + (size_t)layer * DM * MODW + (size_t)(128 * w) * MODW + n0 + lane;
            float acc[5] = {0.f, 0.f, 0.f, 0.f, 0.f};
#pragma unroll 8
            for (int k = 0; k < 128; ++k) { const float wv = wp[(size_t)k * MODW];
#pragma unroll
                for (int rI = 0; rI < 5; ++rI) acc[rI] += cond[rI * DM + 128 * w + k] * wv; }
#pragma unroll
            for (int rI = 0; rI < 5; ++rI) red[(w * 5 + rI) * 64 + lane] = acc[rI];
            __syncthreads();
            if (tid < 320) { const int rI = tid >> 6; float s = KIN(p, 5)[(size_t)layer * MODW + n0 + lane];
#pragma unroll
                for (int ww = 0; ww < 8; ++ww) s += red[(ww * 5 + rI) * 64 + lane];
                ((float*)(KWS(p) + WS_MOD))[((size_t)layer * 5 + rI) * MODW + n0 + lane] = s; }
        } else {
            int t = it - NMOD_ITEMS, j = 0;
            for (; j < 21; ++j) { const int nt = (kJobs[j].K / 64) * (kJobs[j].N / 64); if (t < nt) break; t -= nt; }
            const WJob jb = kJobs[j];
            const int nblk = jb.N / 64, kb = t / nblk, nb = t - kb * nblk, k0 = 64 * kb, n0 = 64 * nb;
            const float* W = KIN(p, jb.in_idx) + jb.src_off;
            __syncthreads();
#pragma unroll
            for (int i = 0; i < 8; ++i) { const int kk = w + 8 * i; scr[lane * 65 + kk] = W[(size_t)(k0 + kk) * jb.N + n0 + lane]; }
            __syncthreads();
            const int n = tid >> 3, c = tid & 7; const LAS float* s = scr + n * 65 + 8 * c;
            u32x4 o; o.x = pk2(s[0], s[1]); o.y = pk2(s[2], s[3]); o.z = pk2(s[4], s[5]); o.w = pk2(s[6], s[7]);
            const int nn = n0 + n; const int drow = jb.kind == 0 ? nn : 256 * (nn >> 7) + (nn & 127) + (jb.kind == 2 ? 128 : 0);
            *(u32x4*)((bf16_t*)(KWS(p) + jb.dst) + (size_t)drow * jb.K + k0 + 8 * c) = o;
        }
    }
    const int gt = bidx() * 512 + tid, NGT = gridDim.x * 512;
    for (int t = gt; t < 64 * 32; t += NGT) { const int pos = t >> 5, i = t & 31; const float f = exp2f(-(float)(2 * i) * (1.0f / 64.0f) * 13.287712379549449f); float sn, cs; sincosf((float)pos * f, &sn, &cs); ((f32x2*)(KWS(p) + WS_ROPEA))[t] = (f32x2){cs, sn}; }
    for (int t = gt; t < 64 * 16; t += NGT) { const int pos = t >> 4, i = t & 15; const float f = exp2f(-(float)(2 * i) * (1.0f / 32.0f) * 13.287712379549449f); float sn, cs; sincosf((float)pos * f, &sn, &cs); ((f32x2*)(KWS(p) + WS_ROPEC))[t] = (f32x2){cs, sn}; }
    for (int t = gt; t < 64 * DM / 8; t += NGT) ((u32x4*)((bf16_t*)(KWS(p) + WS_WC_DQKV) + (size_t)704 * DM))[t] = (u32x4){0u, 0u, 0u, 0u};
    __syncthreads();
}

constexpr int NPHASES = 2 + 9 * DEPTH;
#define PHASE_BEGIN(k) if (lo <= (k) && (k) < hi) { kaptr p = (kaptr)__builtin_amdgcn_kernarg_segment_ptr(); asm volatile("" : "+s"(p)); unsigned char* ws = KWS(p); (void)ws;
#if defined(PROBE_SEAM2)
#define PHASE_END(k) if ((k) + 1 < hi) { gbar((unsigned*)(KWS(p) + WS_BAR), (++nbar) * gridDim.x, wv); gbar((unsigned*)(KWS(p) + WS_BAR), (++nbar) * gridDim.x, wv); } }
#else
#define PHASE_END(k) if ((k) + 1 < hi) gbar((unsigned*)(KWS(p) + WS_BAR), (++nbar) * gridDim.x, wv); }
#endif
DI void gbar(unsigned* ctr, unsigned target, int wv) {
    asm volatile("s_waitcnt vmcnt(0)" ::: "memory");
    __syncthreads();
    if (tidx(wv) == 0) {
        __builtin_amdgcn_fence(__ATOMIC_RELEASE, "agent");
        asm volatile("s_waitcnt vmcnt(0)" ::: "memory");
        __hip_atomic_fetch_add(ctr, 1u, __ATOMIC_RELAXED, __HIP_MEMORY_SCOPE_AGENT);
        while (__hip_atomic_load(ctr, __ATOMIC_RELAXED, __HIP_MEMORY_SCOPE_AGENT) < target) __builtin_amdgcn_s_sleep(2);
        __builtin_amdgcn_fence(__ATOMIC_ACQUIRE, "agent");
        asm volatile("s_waitcnt vmcnt(0)" ::: "memory");
    }
    __syncthreads();
}
template <int LAYER> DI void layer_phases(int lo, int hi, LAS unsigned char* lds, int wv, unsigned& nbar) {
    constexpr int kind = LAYER % 3, inst = LAYER / 3, P0 = 2 + 9 * LAYER; constexpr bool LASTL = LAYER == DEPTH - 1;
    constexpr size_t MODL = WS_MOD + (size_t)LAYER * 5 * MODW * 4;
    PHASE_BEGIN(P0 + 0)
        bf16_t* H = (bf16_t*)(ws + WS_H);
        if constexpr (kind == 0) { const EpiStore E = EpiStore::make((bf16_t*)(ws + WS_AQ), (bf16_t*)(ws + WS_AK), (bf16_t*)(ws + WS_AV), 1024, 1280, 1024, 256, 256, 1536);
            run_gemm(lds, wv, H, (const bf16_t*)(ws + WS_WA_QKV(inst)), MROWS, 1536, DM, E); }
        else if constexpr (kind == 1) { const EpiStore E = EpiStore::make((bf16_t*)(ws + WS_BQ), (bf16_t*)(ws + WS_BK), (bf16_t*)(ws + WS_BV), 1024, 2048, 1024, 1024, 1024, 3072);
            run_gemm(lds, wv, H, (const bf16_t*)(ws + WS_WB_QKV), MROWS, 3072, DM, E); }
        else { const EpiStore E = EpiStore::make((bf16_t*)(ws + WS_CQL), (bf16_t*)(ws + WS_CKVL), (bf16_t*)(ws + WS_CKR), 384, 640, 384, 256, 64, 704);
            run_gemm(lds, wv, H, (const bf16_t*)(ws + WS_WC_DQKV), MROWS, 768, DM, E); }
    PHASE_END(P0 + 0)
    if constexpr (kind == 0) { PHASE_BEGIN(P0 + 1) kpost_a(p, wv, KIN(p, 13) + inst * 128); PHASE_END(P0 + 1) }
    if constexpr (kind == 2) {
        PHASE_BEGIN(P0 + 1) post_c(p, wv, KIN(p, 19), KIN(p, 20)); PHASE_END(P0 + 1)
        PHASE_BEGIN(P0 + 2)
            { const EpiStore E = EpiStore::make((bf16_t*)(ws + WS_CQ), (bf16_t*)(ws + WS_CQ), (bf16_t*)(ws + WS_CQ), 0, 0, 1536, 1536, 1536, 1536);
              run_gemm(lds, wv, (const bf16_t*)(ws + WS_CQL), (const bf16_t*)(ws + WS_WC_UQ), MROWS, 1536, 384, E); }
            { const EpiStore E = EpiStore::make((bf16_t*)(ws + WS_CKV), (bf16_t*)(ws + WS_CKV), (bf16_t*)(ws + WS_CKV), 0, 0, 2048, 2048, 2048, 2048);
              run_gemm(lds, wv, (const bf16_t*)(ws + WS_CKVL), (const bf16_t*)(ws + WS_WC_UKV), MROWS, 2048, 256, E); }
        PHASE_END(P0 + 2)
    }
    PHASE_BEGIN(P0 + 3)
        bf16_t* H = (bf16_t*)(ws + WS_H);
#if defined(PROBE_ATT2)
        for (int rep_ = 0; rep_ < 2; ++rep_) { if (rep_) gbar((unsigned*)(ws + WS_BAR) + 64 + 16 * LAYER, gridDim.x, wv);
#endif
        if constexpr (kind == 0) { const AttnArgs a{(const bf16_t*)(ws + WS_AQ), (const bf16_t*)(ws + WS_AK), (const bf16_t*)(ws + WS_AV), nullptr, H, KIN(p, 12) + inst * 128, nullptr, (const f32x2*)(ws + WS_ROPEA)}; attn_phase<0>(lds, a, wv, LAYER != DEPTH - 1); }
        else if constexpr (kind == 1) { const AttnArgs a{(const bf16_t*)(ws + WS_BQ), (const bf16_t*)(ws + WS_BK), (const bf16_t*)(ws + WS_BV), nullptr, H, nullptr, KIN(p, 16), nullptr}; attn_phase<1>(lds, a, wv, LAYER != DEPTH - 1); }
        else { const AttnArgs a{(const bf16_t*)(ws + WS_CQ), (const bf16_t*)(ws + WS_CKV), (const bf16_t*)(ws + WS_CKV), (const bf16_t*)(ws + WS_CKR), H, nullptr, nullptr, (const f32x2*)(ws + WS_ROPEC)}; attn_phase<2>(lds, a, wv, LAYER != DEPTH - 1); }
#if defined(PROBE_ATT2)
        }
#endif
    PHASE_END(P0 + 3)
    PHASE_BEGIN(P0 + 4)
        constexpr size_t WO = kind == 0 ? WS_WA_O(inst) : (kind == 1 ? WS_WB_O : WS_WC_O);
        const EpiResid E{KOUT(p), (float*)(ws + WS_XC), (const float*)(ws + MODL) + 2 * DM, (float*)(ws + WS_PART)};
        run_gemm_lat(lds, wv, (const bf16_t*)(ws + WS_H), (const bf16_t*)(ws + WO), DM, DM, LASTL ? 0 : 4, E);
    PHASE_END(P0 + 4)
    PHASE_BEGIN(P0 + 5) rows_phase<true>(p, wv, KIN(p, 6) + (size_t)(LAYER * 2 + 0) * DM, KIN(p, 7) + (size_t)(LAYER * 2 + 0) * DM, (const float*)(ws + MODL) + 3 * DM, true, LASTL ? -1 : 4, (const float*)(ws + MODL) + 2 * DM); PHASE_END(P0 + 5)
    PHASE_BEGIN(P0 + 6) const EpiSwiGLU E{(bf16_t*)(ws + WS_ACT)};
#if defined(PROBE_UP2)
        run_gemm(lds, wv, (const bf16_t*)(ws + WS_H), (const bf16_t*)(ws + WS_WGU(LAYER)), MROWS, 2 * DFF, DM, E); gbar((unsigned*)(ws + WS_BAR) + 64 + 16 * LAYER, gridDim.x, wv);
#endif
        if constexpr (LASTL) run_gemm_lat(lds, wv, (const bf16_t*)(ws + WS_H), (const bf16_t*)(ws + WS_WGU(LAYER)), 2 * DFF, DM, 0, E);
        else run_gemm(lds, wv, (const bf16_t*)(ws + WS_H), (const bf16_t*)(ws + WS_WGU(LAYER)), MROWS, 2 * DFF, DM, E);
    PHASE_END(P0 + 6)
    PHASE_BEGIN(P0 + 7) const EpiResid E{KOUT(p), (float*)(ws + WS_XC), (const float*)(ws + MODL) + 5 * DM, (float*)(ws + WS_PART)}; run_gemm_lat(lds, wv, (const bf16_t*)(ws + WS_ACT), (const bf16_t*)(ws + WS_WD(LAYER)), DM, DFF, LASTL ? 0 : 11, E); PHASE_END(P0 + 7)
    PHASE_BEGIN(P0 + 8) constexpr bool last = LAYER == DEPTH - 1;
        rows_phase<true>(p, wv, KIN(p, 6) + (size_t)(LAYER * 2 + 1) * DM, KIN(p, 7) + (size_t)(LAYER * 2 + 1) * DM, (const float*)(ws + MODL) + (last ? 0 : 5 * MODW), !last, LASTL ? -1 : 11, (const float*)(ws + MODL) + 5 * DM); PHASE_END(P0 + 8)
}
static bool phase_exists(int ph) {
    if (ph < 2) return true;
    const int layer = (ph - 2) / 9, step = (ph - 2) - layer * 9, kind = layer % 3;
    if (step == 1) return kind != 1;
    if (step == 2) return kind == 2;
    return true;
}

__global__ void __launch_bounds__(512, 2) mk_fwd(Params prm) {
    extern __shared__ __attribute__((aligned(16))) unsigned char lds_raw[];
    LAS unsigned char* lds = (LAS unsigned char*)lds_raw;
    const int wv = __builtin_amdgcn_readfirstlane((int)(threadIdx.x >> 6));
    const int lo = prm.ph_lo, hi = prm.ph_hi;
    unsigned nbar = 0;
    if (lo <= 0 && 0 < hi) { kaptr p = (kaptr)__builtin_amdgcn_kernarg_segment_ptr(); asm volatile("" : "+s"(p)); prologue_a(p, lds, wv);
        if (1 < hi) cg::this_grid().sync(); }
    PHASE_BEGIN(1) rows_phase<false>(p, wv, nullptr, nullptr, (const float*)(ws + WS_MOD), true); PHASE_END(1)
    layer_phases<0>(lo, hi, lds, wv, nbar);
    layer_phases<1>(lo, hi, lds, wv, nbar);
    layer_phases<2>(lo, hi, lds, wv, nbar);
    layer_phases<3>(lo, hi, lds, wv, nbar);
}

#ifndef MK_MULTI
#define MK_MULTI 0
#endif
extern "C" void kernel_launch(void* const* d_in, const int* in_sizes, int n_in, void* d_out, int out_size, void* d_ws, size_t ws_size, hipStream_t stream) {
    static int grid = 0;
    if (grid == 0) {
        if (n_in != 24 || out_size != NBATCH * SEQ * DM || ws_size < WS_END) { fprintf(stderr, "kernel_launch: unexpected shapes (n_in %d, out %d, ws %zu < %zu)\n", n_in, out_size, ws_size, (size_t)WS_END); grid = -1; return; }
        int dev = 0, cus = 0, per_cu = 0;
        hipGetDevice(&dev); hipDeviceGetAttribute(&cus, hipDeviceAttributeMultiprocessorCount, dev);
        if (hipFuncSetAttribute((const void*)mk_fwd, hipFuncAttributeMaxDynamicSharedMemorySize, LDS_BYTES) != hipSuccess) { fprintf(stderr, "kernel_launch: hipFuncSetAttribute failed\n"); grid = -1; return; }
        if (hipOccupancyMaxActiveBlocksPerMultiprocessor(&per_cu, (const void*)mk_fwd, 512, LDS_BYTES) != hipSuccess || per_cu < 1) { fprintf(stderr, "kernel_launch: occupancy query says %d\n", per_cu); per_cu = 1; }
        (void)hipGetLastError();
        grid = cus * per_cu;
    }
    if (grid < 0) return;
    Params p{};
    for (int i = 0; i < 24; ++i) p.in[i] = (const float*)d_in[i];
    p.out = (float*)d_out; p.ws = (unsigned char*)d_ws;
#if MK_MULTI
    for (int ph = 0; ph < NPHASES; ++ph) {
        if (!phase_exists(ph)) continue;
        p.ph_lo = ph; p.ph_hi = ph + 1;
        hipLaunchKernelGGL(mk_fwd, dim3(grid), dim3(512), LDS_BYTES, stream, p);
    }
#else
    p.ph_lo = 0; p.ph_hi = NPHASES;
    if (hipMemsetAsync((char*)d_ws + WS_BAR, 0, 1024, stream) != hipSuccess) { fprintf(stderr, "kernel_launch: memset of the barrier words failed\n"); return; }
    void* args[] = {&p};
    hipError_t e = hipLaunchCooperativeKernel((const void*)mk_fwd, dim3(grid), dim3(512), args, LDS_BYTES, stream);
    if (e != hipSuccess) fprintf(stderr, "cooperative launch failed: %s (grid %d)\n", hipGetErrorString(e), grid);
#endif
}
```

```cpp
#include <hip/hip_runtime.h>
#include <hip/hip_cooperative_groups.h>
#include <cstdio>
#include <cstdint>
namespace cg = cooperative_groups;
__device__ __forceinline__ int tidx(int wv) { int t = wv * 64 + (int)__builtin_amdgcn_mbcnt_hi(~0u, __builtin_amdgcn_mbcnt_lo(~0u, 0u)); asm volatile("" : "+v"(t)); return t; }
__device__ __forceinline__ int bidx() { int b = blockIdx.x; asm volatile("" : "+s"(b)); return b; }
namespace pg8 {
#define PG8_LAS __attribute__((address_space(3)))
typedef unsigned short bf16_t;
typedef short bf16x8 __attribute__((ext_vector_type(8)));
typedef float f32x4 __attribute__((ext_vector_type(4)));
typedef unsigned u32x4 __attribute__((ext_vector_type(4)));
constexpr int BM = 256, BK = 64, HALF = 128, HTB = HALF * BK * 2  , STAGE_BYTES = 8 * HTB, NXCD = 8, WGM = 8;

__host__ __device__ __forceinline__ int lds_byte(int r, int c) { const int st = (r >> 4) * 2 + (c >> 5), rr = r & 15, cc = c & 31, ob = rr * 64 + cc * 2; return st * 1024 + (ob ^ (((ob >> 9) & 1) << 5)); }
__host__ __device__ __forceinline__ void stage_rc(int b, int& R, int& C) { const int st = b / 1024, sb = b % 1024, swz = sb ^ (((sb >> 9) & 1) << 5); R = (st >> 1) * 16 + swz / 64; C = (st & 1) * 32 + (swz % 64) / 2; }
__host__ __device__ __forceinline__ int perm32(int rho) { const int n = rho >> 4, i = rho & 15; return 8 * (i >> 2) + 4 * n + (i & 3); }

struct Unit { int pm, pn, k0, nt, ks; };
struct Gemm { const bf16_t* A; const bf16_t* Bt; int M, N, K; };

struct StaticOrder {
    int nM, nN, nwg, G, c, ntk;
    __host__ __device__ void init(int M, int N, int G_, int c_) { nM = M / BM; nN = N / BM; nwg = nM * nN; G = G_; c = c_; }
    __host__ __device__ bool next(int i, Unit& u) const {
        const long L = (long)i * G + c; if (L >= nwg) return false;
        int wgid = (int)L; { const int q = nwg / NXCD, r = nwg % NXCD, xcd = wgid % NXCD, off = wgid / NXCD; wgid = (xcd < r ? xcd * (q + 1) : r * (q + 1) + (xcd - r) * q) + off; }
        const int nig = WGM * nN, gid = wgid / nig, fm = gid * WGM, gsz = (nM - fm) < WGM ? (nM - fm) : WGM;
        u.pm = fm + ((wgid % nig) % gsz); u.pn = (wgid % nig) / gsz; u.k0 = 0; u.nt = ntk; u.ks = -1; return true;
    }
    __device__ __forceinline__ void a_ready(const Unit&) const {}
    __device__ __forceinline__ void done(const Unit&) const {}
};
template <class Epi, class Sched, bool ALIGN_EPI = false, bool SP2 = false>
__device__ __forceinline__ void gemm_phase(PG8_LAS unsigned char* lds, const Gemm g, const Sched& S, const Epi& E, int wv) {
    const int tid = tidx(wv), wid = __builtin_amdgcn_readfirstlane(tid >> 6), lane = tid & 63, wr = wid >> 2, wc = wid & 3, fr = lane & 15, fq = lane >> 4;
    const int K = g.K;
    unsigned voffA[2], voffB[2];
#pragma unroll
    for (int i = 0; i < 2; ++i) { int R, C; stage_rc(tid * 16 + i * 8192, R, C); const int Rb = Epi::PERM ? ((R & ~31) + perm32(R & 31)) : R;
        voffA[i] = (unsigned)(R * K + C) * 2u; voffB[i] = (unsigned)(Rb * K + C) * 2u; }
    const size_t kstep = (size_t)(BK * 2);
    const size_t hstep = (size_t)HALF * K * 2;
    const size_t tstep = 2 * hstep;
    const unsigned ldsw = (unsigned)wid * 1024u;
    const int aoff = lds_byte(wr * 64 + fr, fq * 8), boff = lds_byte(wc * 32 + fr, fq * 8);
#define PG8_SA(b, h) (((b) * 2 + (h)) * HTB)
#define PG8_SB(b, h) ((4 + (b) * 2 + (h)) * HTB)
#define PG8_STAGE(bufoff, gbase, voff) do { _Pragma("unroll") for (int _i = 0; _i < 2; ++_i) \
        __builtin_amdgcn_global_load_lds((const unsigned*)((const char*)(gbase) + (voff)[_i]), (PG8_LAS unsigned*)(lds + (bufoff) + ldsw + _i * 8192), 16, 0, 0); } while (0)
#define PG8_LDA(dst, b, h) do { _Pragma("unroll") for (int m = 0; m < 4; ++m) _Pragma("unroll") for (int k = 0; k < 2; ++k) dst[m][k] = *(const PG8_LAS bf16x8*)(lds + PG8_SA(b, h) + aoff + m * 2048 + k * 1024); } while (0)
#define PG8_LDB(dst, b, h) do { _Pragma("unroll") for (int n = 0; n < 2; ++n) _Pragma("unroll") for (int k = 0; k < 2; ++k) dst[n][k] = *(const PG8_LAS bf16x8*)(lds + PG8_SB(b, h) + boff + n * 2048 + k * 1024); } while (0)
#define PG8_MMA(ai, bj, At, Bt) do { __builtin_amdgcn_s_setprio(1); _Pragma("unroll") for (int m = 0; m < 4; ++m) _Pragma("unroll") for (int n = 0; n < 2; ++n) _Pragma("unroll") for (int k = 0; k < 2; ++k) \
        acc[ai][bj][m][n] = __builtin_amdgcn_mfma_f32_16x16x32_bf16(Bt[n][k], At[m][k], acc[ai][bj][m][n], 0, 0, 0); __builtin_amdgcn_s_setprio(0); } while (0)
#define PG8_WAIT_V(n) asm volatile("s_waitcnt vmcnt(" #n ")" ::: "memory")
#define PG8_WAIT_L(n) asm volatile("s_waitcnt lgkmcnt(" #n ")" ::: "memory")
#define PG8_BAR __builtin_amdgcn_s_barrier()
#define PG8_SCHED __builtin_amdgcn_sched_barrier(0)
    Unit cur, nxt; int ui = 0;
    if (!S.next(0, cur)) return;
    f32x4 acc[2][2][4][2];
#pragma unroll
    for (int a = 0; a < 2; ++a)
#pragma unroll
        for (int b = 0; b < 2; ++b)
#pragma unroll
            for (int m = 0; m < 4; ++m)
#pragma unroll
                for (int n = 0; n < 2; ++n) acc[a][b][m][n] = (f32x4){0.f, 0.f, 0.f, 0.f};
    bf16x8 At[4][2], B0[2][2], B1[2][2];
    const char* cA = (const char*)g.A + (size_t)cur.pm * tstep + (size_t)cur.k0 * 2; const char* cB = (const char*)g.Bt + (size_t)cur.pn * tstep + (size_t)cur.k0 * 2;
    int nt = cur.nt;
    S.a_ready(cur);
    if constexpr (SP2) {
        PG8_STAGE(PG8_SB(0, 0), cB, voffB); PG8_STAGE(PG8_SB(0, 1), cB + hstep, voffB); PG8_STAGE(PG8_SA(0, 0), cA, voffA); PG8_STAGE(PG8_SA(0, 1), cA + hstep, voffA);
        if (wr == 1) PG8_BAR;
        PG8_WAIT_V(2); PG8_BAR;
        PG8_STAGE(PG8_SB(1, 0), cB + kstep, voffB); PG8_STAGE(PG8_SA(1, 0), cA + kstep, voffA); PG8_STAGE(PG8_SB(1, 1), cB + hstep + kstep, voffB);
        PG8_WAIT_V(6); PG8_BAR;
    } else {
        PG8_STAGE(PG8_SB(0, 0), cB, voffB); PG8_STAGE(PG8_SA(0, 0), cA, voffA); PG8_STAGE(PG8_SB(0, 1), cB + hstep, voffB); PG8_STAGE(PG8_SA(0, 1), cA + hstep, voffA);
        if (wr == 1) PG8_BAR;
        PG8_WAIT_V(4); PG8_BAR;
        PG8_STAGE(PG8_SB(1, 0), cB + kstep, voffB); PG8_STAGE(PG8_SA(1, 0), cA + kstep, voffA); PG8_STAGE(PG8_SB(1, 1), cB + hstep + kstep, voffB);
        PG8_WAIT_V(6); PG8_BAR;
    }
    for (;;) {
        const bool has_next = S.next(ui + 1, nxt);
        const char* nA = has_next ? (const char*)g.A + (size_t)nxt.pm * tstep + (size_t)nxt.k0 * 2 : cA; const char* nB = has_next ? (const char*)g.Bt + (size_t)nxt.pn * tstep + (size_t)nxt.k0 * 2 : cB;
        for (int t = 0; t < nt; t += 2) {
            const bool last = (t == nt - 2);
            const char* a1 = cA + (size_t)(t + 1) * kstep;
            const char* a2 = last ? nA : cA + (size_t)(t + 2) * kstep; const char* b2 = last ? nB : cB + (size_t)(t + 2) * kstep;
            const char* a3 = a2 + kstep; const char* b3 = b2 + kstep;
            if (last && has_next) S.a_ready(nxt);
            if constexpr (SP2) {
            PG8_LDB(B0, 0, 0); PG8_LDB(B1, 0, 1); PG8_SCHED; PG8_LDA(At, 0, 0); PG8_STAGE(PG8_SA(1, 1), a1 + hstep, voffA);
            PG8_WAIT_V(8); PG8_WAIT_L(0); PG8_BAR; PG8_MMA(0, 0, At, B0); PG8_MMA(0, 1, At, B1); PG8_BAR; PG8_SCHED;
            PG8_LDA(At, 0, 1); PG8_STAGE(PG8_SB(0, 0), b2, voffB); PG8_STAGE(PG8_SB(0, 1), b2 + hstep, voffB); PG8_STAGE(PG8_SA(0, 0), a2, voffA);
            PG8_WAIT_V(8); PG8_WAIT_L(0); PG8_BAR; PG8_MMA(1, 0, At, B0); PG8_MMA(1, 1, At, B1); PG8_BAR; PG8_SCHED;
            PG8_LDB(B0, 1, 0); PG8_LDB(B1, 1, 1); PG8_SCHED; PG8_LDA(At, 1, 0); PG8_STAGE(PG8_SA(0, 1), a2 + hstep, voffA);
            PG8_WAIT_V(8); PG8_WAIT_L(0); PG8_BAR; PG8_MMA(0, 0, At, B0); PG8_MMA(0, 1, At, B1); PG8_BAR; PG8_SCHED;
            PG8_LDA(At, 1, 1); PG8_STAGE(PG8_SB(1, 0), b3, voffB); PG8_STAGE(PG8_SB(1, 1), b3 + hstep, voffB); PG8_STAGE(PG8_SA(1, 0), a3, voffA);
            PG8_WAIT_V(8); PG8_WAIT_L(0); PG8_BAR; PG8_MMA(1, 0, At, B0); PG8_MMA(1, 1, At, B1); PG8_BAR; PG8_SCHED;
            } else {
            PG8_LDB(B0, 0, 0); PG8_SCHED; PG8_LDA(At, 0, 0); PG8_STAGE(PG8_SA(1, 1), a1 + hstep, voffA);
            PG8_WAIT_L(8); PG8_BAR; PG8_WAIT_L(0); PG8_MMA(0, 0, At, B0); PG8_BAR; PG8_SCHED;
            PG8_LDB(B1, 0, 1); PG8_STAGE(PG8_SB(0, 0), b2, voffB);
            PG8_BAR; PG8_WAIT_L(0); PG8_MMA(0, 1, At, B1); PG8_BAR;
            PG8_LDA(At, 0, 1); PG8_STAGE(PG8_SA(0, 0), a2, voffA);
            PG8_BAR; PG8_WAIT_L(0); PG8_MMA(1, 0, At, B0); PG8_BAR; PG8_SCHED;
            PG8_STAGE(PG8_SB(0, 1), b2 + hstep, voffB);
            PG8_WAIT_V(6); PG8_BAR; PG8_MMA(1, 1, At, B1); PG8_BAR;
            PG8_LDB(B0, 1, 0); PG8_SCHED; PG8_LDA(At, 1, 0); PG8_STAGE(PG8_SA(0, 1), a2 + hstep, voffA);
            PG8_WAIT_L(8); PG8_BAR; PG8_WAIT_L(0); PG8_MMA(0, 0, At, B0); PG8_BAR; PG8_SCHED;
            PG8_LDB(B1, 1, 1); PG8_STAGE(PG8_SB(1, 0), b3, voffB);
            PG8_BAR; PG8_WAIT_L(0); PG8_MMA(0, 1, At, B1); PG8_BAR;
            PG8_LDA(At, 1, 1); PG8_STAGE(PG8_SA(1, 0), a3, voffA);
            PG8_BAR; PG8_WAIT_L(0); PG8_MMA(1, 0, At, B0); PG8_BAR; PG8_SCHED;
            PG8_STAGE(PG8_SB(1, 1), b3 + hstep, voffB);
            PG8_WAIT_V(6); PG8_BAR; PG8_MMA(1, 1, At, B1); PG8_BAR;
            }
        }
        if constexpr (ALIGN_EPI) { if (wr == 0) PG8_BAR; }
        if constexpr (!Epi::AFTER_DRAIN) { E(acc, cur, wr, wc, fr, fq); S.done(cur); }
        if (!has_next) break;
#pragma unroll
        for (int a = 0; a < 2; ++a)
#pragma unroll
            for (int b = 0; b < 2; ++b)
#pragma unroll
                for (int m = 0; m < 4; ++m)
#pragma unroll
                    for (int n = 0; n < 2; ++n) acc[a][b][m][n] = (f32x4){0.f, 0.f, 0.f, 0.f};
        cur = nxt; cA = nA; cB = nB; ++ui; nt = cur.nt;
        if constexpr (ALIGN_EPI) { if (wr == 1) PG8_BAR; }
    }
    PG8_WAIT_V(0);
    if constexpr (!ALIGN_EPI) { if (wr == 0) PG8_BAR; }
    PG8_BAR;
    if constexpr (Epi::AFTER_DRAIN) { E.fused(acc, cur, wr, wc, fr, fq, lds, wid, lane); S.done(cur); }
#undef PG8_SA
#undef PG8_SB
#undef PG8_STAGE
#undef PG8_LDA
#undef PG8_LDB
#undef PG8_MMA
#undef PG8_WAIT_V
#undef PG8_WAIT_L
#undef PG8_BAR
#undef PG8_SCHED
}
}

#define LAS __attribute__((address_space(3)))
#define DI __device__ __forceinline__
using pg8::bf16_t; using pg8::bf16x8; using pg8::f32x4; using pg8::u32x4;
typedef short s16x4 __attribute__((ext_vector_type(4)));
typedef float f32x16 __attribute__((ext_vector_type(16)));
typedef float f32x2 __attribute__((ext_vector_type(2)));
typedef unsigned u32x2 __attribute__((ext_vector_type(2)));
typedef __bf16 bf16x2_t __attribute__((ext_vector_type(2)));

constexpr int NBATCH = 4, SEQ = 4096, CTXL = 256, TPB = 4352, MROWS = NBATCH * TPB, DM = 1024, DFF = 2816, DEPTH = 4, MODW = 6 * DM;
constexpr float ALPHA = 1.6817928305074290f, LOG2E = 1.4426950408889634f;
constexpr size_t MiB = 1048576;
constexpr size_t WS_MOD = 0, WS_ROPEA = 512 * 1024, WS_ROPEC = WS_ROPEA + 16384, WS_BAR = WS_ROPEC + 8192  , WS_XC = 1 * MiB, WS_H = 5 * MiB, WS_W = 39 * MiB;
constexpr size_t WS_WGU(int l) { return WS_W + (size_t)l * (33 * MiB / 2); }
constexpr size_t WS_WD(int l) { return WS_WGU(l) + 11 * MiB; }
constexpr size_t WS_WA_QKV(int j) { return WS_W + 66 * MiB + (size_t)j * 5 * MiB; }
constexpr size_t WS_WA_O(int j) { return WS_WA_QKV(j) + 3 * MiB; }
constexpr size_t WS_WB_QKV = WS_W + 76 * MiB, WS_WB_O = WS_WB_QKV + 6 * MiB;
constexpr size_t WS_WC_DQKV = WS_W + 84 * MiB, WS_WC_UQ = WS_WC_DQKV + 3 * MiB / 2, WS_WC_UKV = WS_WC_UQ + 9 * MiB / 8, WS_WC_O = WS_WC_UKV + 1 * MiB;
constexpr size_t WS_R = 129 * MiB;
constexpr size_t WS_AQ = WS_R, WS_AK = WS_R + 34 * MiB, WS_AV = WS_AK + 17 * MiB / 2;
constexpr size_t WS_BQ = WS_R, WS_BK = WS_R + 34 * MiB, WS_BV = WS_R + 68 * MiB;
constexpr size_t WS_CQ = WS_R, WS_CKV = WS_R + 51 * MiB, WS_CKR = WS_R + 119 * MiB, WS_CQL = WS_R + 122 * MiB, WS_CKVL = WS_R + 135 * MiB;
constexpr size_t WS_ACT = WS_R, WS_PART = WS_R + 96 * MiB  ;
constexpr size_t WS_END = WS_R + 144 * MiB;
static_assert(WS_WC_O + 2 * MiB <= WS_R, "weights fit");

constexpr int LDS_BYTES = 147456;

struct Params { const float* in[24]; float* out; unsigned char* ws; int ph_lo, ph_hi; };
typedef const __attribute__((address_space(4))) unsigned char* kaptr;
DI const float* KIN(kaptr ka, int i) { return *(const float* const __attribute__((address_space(4)))*)(ka + 8 * i); }
DI float* KOUT(kaptr ka) { return *(float* const __attribute__((address_space(4)))*)(ka + 192); }
DI unsigned char* KWS(kaptr ka) { return *(unsigned char* const __attribute__((address_space(4)))*)(ka + 200); }

DI unsigned pk2(float lo, float hi) { f32x2 v = {lo, hi}; return __builtin_bit_cast(unsigned, __builtin_convertvector(v, bf16x2_t)); }
DI float bflo(unsigned u) { return __uint_as_float(u << 16); }
DI float bfhi(unsigned u) { return __uint_as_float(u & 0xffff0000u); }
DI void unpack8(const u32x4 w, float (&f)[8]) { f[0] = bflo(w.x); f[1] = bfhi(w.x); f[2] = bflo(w.y); f[3] = bfhi(w.y); f[4] = bflo(w.z); f[5] = bfhi(w.z); f[6] = bflo(w.w); f[7] = bfhi(w.w); }
DI u32x4 pack8(const float (&f)[8]) { u32x4 w; w.x = pk2(f[0], f[1]); w.y = pk2(f[2], f[3]); w.z = pk2(f[4], f[5]); w.w = pk2(f[6], f[7]); return w; }
DI float wave_sum(float v) {
#pragma unroll
    for (int o = 1; o < 64; o <<= 1) v += __shfl_xor(v, o);
    return v;
}
DI float silu_f(float x) { return x * __builtin_amdgcn_rcpf(1.0f + __expf(-x)); }

struct EpiStore {
    static constexpr bool PERM = true, AFTER_DRAIN = false;
    bf16_t* p2; long long d12, d01; int ld2, dl12, dl01, c1, c2, nvalid;
    static DI EpiStore make(bf16_t* p0, bf16_t* p1, bf16_t* p2, int c1, int c2, int ld0, int ld1, int ld2, int nvalid) {
        EpiStore e; e.p2 = p2; e.d12 = (long long)(p1 - p2); e.d01 = (long long)(p0 - p1); e.ld2 = ld2; e.dl12 = ld1 - ld2; e.dl01 = ld0 - ld1; e.c1 = c1; e.c2 = c2; e.nvalid = nvalid; return e; }
    DI void operator()(const f32x4 (&acc)[2][2][4][2], const pg8::Unit& u, int wr, int wc, int fr, int fq) const {
        const int row0 = u.pm * 256 + wr * 64 + fr;
#pragma unroll
        for (int bj = 0; bj < 2; ++bj) {
            const int col = u.pn * 256 + bj * 128 + wc * 32 + 8 * fq;
            const int m0 = -(int)(col < c1), m1 = -(int)(col < c2);
            bf16_t* base = p2 + ((d12 & (long long)m1) + (d01 & (long long)m0));
            const int ld = ld2 + (dl12 & m1) + (dl01 & m0), lc = col - c2 + ((c2 - c1) & m1) + (c1 & m0);
            if (col < nvalid) {
#pragma unroll
                for (int ai = 0; ai < 2; ++ai)
#pragma unroll
                    for (int m = 0; m < 4; ++m) {
                        const f32x4 v0 = acc[ai][bj][m][0], v1 = acc[ai][bj][m][1];
                        u32x4 w; w.x = pk2(v0[0], v0[1]); w.y = pk2(v0[2], v0[3]); w.z = pk2(v1[0], v1[1]); w.w = pk2(v1[2], v1[3]);
                        *(u32x4*)(base + (size_t)(row0 + ai * 128 + m * 16) * ld + lc) = w;
                    }
            }
        }
    }
};
struct EpiResid {
    static constexpr bool PERM = true, AFTER_DRAIN = false;
    bf16_t* Y; float* part;
    DI void operator()(const f32x4 (&acc)[2][2][4][2], const pg8::Unit& u, int wr, int wc, int fr, int fq) const {
        const int rl = wr * 64 + fr;
        if (u.ks >= 0) {
            const int b = u.pm / 17;
            float* pb = part + ((size_t)u.ks * 1024 + (size_t)b * 256) * DM;
#pragma unroll
            for (int bj = 0; bj < 2; ++bj) {
                const int col = u.pn * 256 + bj * 128 + wc * 32 + 8 * fq;
#pragma unroll
                for (int ai = 0; ai < 2; ++ai)
#pragma unroll
                    for (int m = 0; m < 4; ++m) {
                        float* xp = pb + (size_t)(rl + ai * 128 + m * 16) * DM + col;
                        *(f32x4*)xp = acc[ai][bj][m][0]; *(f32x4*)(xp + 4) = acc[ai][bj][m][1];
                    }
            }
            return;
        }
        bf16_t* yb = Y + (size_t)(u.pm * 256 + rl) * DM;
#pragma unroll
        for (int bj = 0; bj < 2; ++bj) {
            const int col = u.pn * 256 + bj * 128 + wc * 32 + 8 * fq;
#pragma unroll
            for (int ai = 0; ai < 2; ++ai)
#pragma unroll
                for (int m = 0; m < 4; ++m) {
                    const f32x4 v0 = acc[ai][bj][m][0], v1 = acc[ai][bj][m][1];
                    u32x4 w; w.x = pk2(v0[0], v0[1]); w.y = pk2(v0[2], v0[3]); w.z = pk2(v1[0], v1[1]); w.w = pk2(v1[2], v1[3]);
                    *(u32x4*)(yb + (size_t)(ai * 128 + m * 16) * DM + col) = w;
                }
        }
    }
};
struct EpiSwiGLU {
    static constexpr bool PERM = true, AFTER_DRAIN = false;
    bf16_t* act;
    DI void operator()(const f32x4 (&acc)[2][2][4][2], const pg8::Unit& u, int wr, int wc, int fr, int fq) const {
        const int row0 = u.pm * 256 + wr * 64 + fr, col = u.pn * 128 + wc * 32 + 8 * fq;
#pragma unroll
        for (int ai = 0; ai < 2; ++ai)
#pragma unroll
            for (int m = 0; m < 4; ++m) {
                const f32x4 a0 = acc[ai][0][m][0], a1 = acc[ai][0][m][1], b0 = acc[ai][1][m][0], b1 = acc[ai][1][m][1];
                u32x4 w;
                w.x = pk2(silu_f(a0[0]) * b0[0], silu_f(a0[1]) * b0[1]); w.y = pk2(silu_f(a0[2]) * b0[2], silu_f(a0[3]) * b0[3]);
                w.z = pk2(silu_f(a1[0]) * b1[0], silu_f(a1[1]) * b1[1]); w.w = pk2(silu_f(a1[2]) * b1[2], silu_f(a1[3]) * b1[3]);
                *(u32x4*)(act + (size_t)(row0 + ai * 128 + m * 16) * DFF + col) = w;
            }
    }
};
template <class Epi> DI void run_gemm(LAS unsigned char* lds, int wv, const bf16_t* A, const bf16_t* Bt, int M, int N, int K, const Epi& E) {
    pg8::Gemm g{A, Bt, M, N, K}; pg8::StaticOrder S; S.init(M, N, (int)gridDim.x, bidx()); S.ntk = K / 64;
    pg8::gemm_phase<Epi, pg8::StaticOrder, true, true>(lds, g, S, E, wv);
}
struct LatCtxOrder {
    pg8::StaticOrder so; int KS, nsplit, G, c;
    DI void init(int N, int K, int KS_, int G_, int c_) { so.init(NBATCH * SEQ, N, G_, c_); so.ntk = K / 64; KS = KS_; nsplit = 4 * (N / 256) * KS_; G = G_; c = c_; }
    DI bool next(int i, pg8::Unit& u) const {
        const int L = i * G + c;
        if (L < so.nwg) { so.next(i, u); u.pm += u.pm >> 4; return true; }
        const int s = L - so.nwg; if (s >= nsplit) return false;
        const int kp = s % KS, u16 = s / KS, nN = so.nN;
        u.pm = 17 * (u16 / nN) + 16; u.pn = u16 % nN; u.nt = so.ntk / KS; u.k0 = kp * u.nt * 64; u.ks = kp; return true;
    }
    DI void a_ready(const pg8::Unit&) const {}
    DI void done(const pg8::Unit&) const {}
};
template <class Epi> DI void run_gemm_lat(LAS unsigned char* lds, int wv, const bf16_t* A, const bf16_t* Bt, int N, int K, int KS, const Epi& E) {
    pg8::Gemm g{A, Bt, MROWS, N, K}; LatCtxOrder S; S.init(N, K, KS, (int)gridDim.x, bidx());
    pg8::gemm_phase<Epi, LatCtxOrder, true, true>(lds, g, S, E, wv);
}

struct AttnArgs { const bf16_t* Q; const bf16_t* K; const bf16_t* V; const bf16_t* K2; bf16_t* O; const float* gain; const float* rpb; const f32x2* rope; };
DI int crow(int i, int h) { return (i & 3) + 8 * (i >> 2) + 4 * h; }

template <int MODE> DI void attn_phase(LAS unsigned char* lds, const AttnArgs a, int wv, bool with_ctx) {
    constexpr int DK = MODE == 0 ? 128 : (MODE == 1 ? 64 : 192), DV = MODE == 1 ? 64 : 128;
    constexpr int KT = MODE == 2 ? 192 : 128, VT = 128;
    constexpr int KSTR = KT * 2 + 16, VSTR = VT * 2 + 64, VOFF = 64 * KSTR, BOFF = VOFF + 64 * VSTR;
    constexpr int KCH = KT / 8, VCH = VT / 8, NKC = KT / 64, NVC = VT / 64, NS = DK / 16, NVB = DV / 32;
    constexpr int QLD = MODE == 2 ? 1536 : 1024;
    constexpr float QS = (MODE == 0 ? 0.08838834764831845f : (MODE == 1 ? 0.125f : 0.07216878364870322f)) * LOG2E;
    const int tid = tidx(wv), w = __builtin_amdgcn_readfirstlane(tid >> 6);
    const int nunits = MODE == 1 ? (with_ctx ? 1088 : 1024) : (with_ctx ? 544 : 512);
    const int kc0 = MODE == 1 ? 64 * ((w >> 1) & 1) : 0;
    for (int it_ = bidx(); it_ < nunits; it_ += gridDim.x) {
        int u = it_;
        if (MODE != 1 && gridDim.x == 256 && it_ < 512) u = (((it_ >> 8) * 8 + (it_ & 7)) * 32) + ((it_ >> 3) & 31);
        int tu_ = tid; asm volatile("" : "+v"(tu_));
        const int lane = tu_ & 63, r = lane & 31, h = lane >> 5;
        int b, head, hq = 0, qpos, nloc, base0, ntiles, rr = 0, rs = 0, rs0 = 0;
        if (MODE == 1) {
            if (u < 1024) { b = u >> 8; const int rp = (u >> 3) & 31; hq = u & 7; rr = 2 * rp + (w >> 2); qpos = rr * 64 + 32 * (w & 1) + r;
                const int rsA = min(max(2 * rp - 4, 0), 56), rsB = min(max(2 * rp - 3, 0), 56); rs = (w >> 2) ? rsB : rsA; rs0 = rsA; nloc = rsB - rsA + 8; base0 = rsA * 64; ntiles = nloc + 4; }
            else { const int v = u - 1024; b = v >> 4; hq = v & 7; qpos = 4096 + (2 * ((v >> 3) & 1) + (w >> 2)) * 64 + 32 * (w & 1) + r; nloc = 0; base0 = 0; ntiles = 4; }
            head = 2 * hq + ((w >> 1) & 1);
        } else {
            if (u < 512) { b = u >> 7; head = (u >> 4) & 7; qpos = (u & 15) * 256 + 32 * w + r; nloc = 68; base0 = 0; ntiles = 68; }
            else { const int v = u - 512; b = v >> 3; head = v & 7; qpos = 4096 + 32 * w + r; nloc = 0; base0 = 0; ntiles = 4; }
        }
        const int kvh = head >> 2;
        const size_t rowb = (size_t)b * TPB;
        const bool lat = qpos < 4096;
        bf16x8 qf[NS];
        {
            const bf16_t* qp = a.Q + (rowb + qpos) * QLD + head * DK + 8 * h;
            u32x4 qraw[NS];
#pragma unroll
            for (int s = 0; s < NS; ++s) qraw[s] = *(const u32x4*)(qp + 16 * s);
            if (MODE == 0) {
                float ss = 0.f;
#pragma unroll
                for (int s = 0; s < NS; ++s) { float f[8]; unpack8(qraw[s], f);
#pragma unroll
                    for (int e = 0; e < 8; ++e) ss += f[e] * f[e]; }
                ss += __shfl_xor(ss, 32);
                const float rstd = rsqrtf(ss * (1.0f / 128.0f) + 1e-6f) * QS;
                const int pr = qpos >> 6, pc = qpos & 63;
#pragma unroll
                for (int g = 0; g < 4; ++g) {
                    const int s0 = (g & 1) + 4 * (g >> 1), s1 = s0 + 2, pos = (g >> 1) ? pc : pr, i0 = 16 * (g & 1) + 8 * h;
                    float t1[8], t2[8], o1[8], o2[8]; unpack8(qraw[s0], t1); unpack8(qraw[s1], t2);
                    const float* g1 = a.gain + 16 * s0 + 8 * h; const float* g2 = a.gain + 16 * s1 + 8 * h;
#pragma unroll
                    for (int e = 0; e < 8; ++e) {
                        f32x2 cs = a.rope[pos * 32 + i0 + e]; if (!lat) { cs.x = 1.f; cs.y = 0.f; }
                        const float x1 = t1[e] * rstd * g1[e], x2 = t2[e] * rstd * g2[e];
                        o1[e] = x1 * cs.x - x2 * cs.y; o2[e] = x2 * cs.x + x1 * cs.y;
                    }
                    qraw[s0] = pack8(o1); qraw[s1] = pack8(o2);
                    asm volatile("" ::: "memory");
                }
            } else if (MODE == 1) {
#pragma unroll
                for (int s = 0; s < NS; ++s) { float f[8]; unpack8(qraw[s], f);
#pragma unroll
                    for (int e = 0; e < 8; ++e) f[e] *= QS;
                    qraw[s] = pack8(f); }
            } else {
#pragma unroll
                for (int s = 0; s < 8; ++s) { float f[8]; unpack8(qraw[s], f);
#pragma unroll
                    for (int e = 0; e < 8; ++e) f[e] *= QS;
                    qraw[s] = pack8(f); }
#ifndef EXP_NOROPE2
                const int pr = qpos >> 6, pc = qpos & 63;
#pragma unroll
                for (int g = 0; g < 2; ++g) {
                    const int s0 = 8 + 2 * g, s1 = s0 + 1, pos = g ? pc : pr;
                    float t1[8], t2[8], o1[8], o2[8]; unpack8(qraw[s0], t1); unpack8(qraw[s1], t2);
#pragma unroll
                    for (int e = 0; e < 8; ++e) {
                        f32x2 cs = a.rope[pos * 16 + 8 * h + e]; if (!lat) { cs.x = 1.f; cs.y = 0.f; }
                        const float x1 = t1[e] * QS, x2 = t2[e] * QS;
                        o1[e] = x1 * cs.x - x2 * cs.y; o2[e] = x2 * cs.x + x1 * cs.y;
                    }
                    qraw[s0] = pack8(o1); qraw[s1] = pack8(o2);
                    asm volatile("" ::: "memory");
                }
#endif
            }
#pragma unroll
            for (int s = 0; s < NS; ++s) qf[s] = __builtin_bit_cast(bf16x8, qraw[s]);
        }
        __syncthreads();
        if (MODE == 1 && nloc > 0) {
            LAS float* bl = (LAS float*)(lds + BOFF);
            for (int t = tid; t < 2 * 465; t += 512) bl[t] = a.rpb[(size_t)(2 * hq) * 465 + t] * LOG2E;
        }
        f32x16 oacc[NVB];
#pragma unroll
        for (int vb = 0; vb < NVB; ++vb)
#pragma unroll
            for (int i = 0; i < 16; ++i) oacc[vb][i] = 0.f;
        float mrun = 0.f, lrun = 0.f;
        u32x4 kreg[NKC], vreg[NVC];
#define ATT_LOAD_TILE(kp) do { \
        _Pragma("unroll") for (int i_ = 0; i_ < NKC; ++i_) { const int ci = tl_ + 512 * i_, kr = ci / KCH, cc = ci - kr * KCH; const size_t row = rowb + (kp) + kr; const bf16_t* src; \
            if (MODE == 0) src = a.K + row * 256 + kvh * 128 + cc * 8; else if (MODE == 1) src = a.K + row * 1024 + hq * 128 + cc * 8; \
            else src = (cc < 16) ? a.K + row * 2048 + head * 256 + cc * 8 : a.K2 + row * 64 + (cc - 16) * 8; \
            kreg[i_] = *(const u32x4*)src; } \
        _Pragma("unroll") for (int i_ = 0; i_ < NVC; ++i_) { const int ci = tl_ + 512 * i_, kr = ci / VCH, cc = ci - kr * VCH; const size_t row = rowb + (kp) + kr; const bf16_t* src; \
            if (MODE == 0) src = a.V + row * 256 + kvh * 128 + cc * 8; else if (MODE == 1) src = a.V + row * 1024 + hq * 128 + cc * 8; \
            else src = a.V + row * 2048 + head * 256 + 128 + cc * 8; \
            vreg[i_] = *(const u32x4*)src; } } while (0)
        { int tl_ = tid; asm volatile("" : "+v"(tl_)); ATT_LOAD_TILE(nloc > 0 ? base0 : 4096); }
        for (int j = 0; j < ntiles; ++j) {
            int tl_ = tid; asm volatile("" : "+v"(tl_));
            const int ln_ = tl_ & 63, r = ln_ & 31, h = ln_ >> 5;
            __syncthreads();
#pragma unroll
            for (int i_ = 0; i_ < NKC; ++i_) { const int ci = tl_ + 512 * i_, kr = ci / KCH, cc = ci - kr * KCH; *(LAS u32x4*)(lds + kr * KSTR + cc * 16) = kreg[i_]; }
#pragma unroll
            for (int i_ = 0; i_ < NVC; ++i_) { const int ci = tl_ + 512 * i_, kr = ci / VCH, cc = ci - kr * VCH; *(LAS u32x4*)(lds + VOFF + kr * VSTR + cc * 16) = vreg[i_]; }
            __syncthreads();
            if (j + 1 < ntiles) { const int jn = j + 1; const int kpn = jn < nloc ? base0 + 64 * jn : 4096 + 64 * (jn - nloc); ATT_LOAD_TILE(kpn); }
            if (!(MODE == 1 && j < nloc && (rs0 + j < rs || rs0 + j > rs + 7))) {
            f32x16 sacc[2];
#pragma unroll
            for (int kb = 0; kb < 2; ++kb)
#pragma unroll
                for (int i = 0; i < 16; ++i) sacc[kb][i] = -mrun;
#pragma unroll
            for (int s = 0; s < NS; ++s) {
#pragma unroll
                for (int kb = 0; kb < 2; ++kb) {
                    const bf16x8 kf = *(const LAS bf16x8*)(lds + (32 * kb + r) * KSTR + (kc0 + 16 * s + 8 * h) * 2);
                    sacc[kb] = __builtin_amdgcn_mfma_f32_32x32x16_bf16(kf, qf[s], sacc[kb], 0, 0, 0);
                }
                if ((s & 1) == 1) asm volatile("" ::: "memory");
            }
            if (MODE == 1 && j < nloc) {
                const int c = qpos & 63, cs = min(max(c - 8, 0), 48), dr = rs0 + j - rr + 7;
                const LAS float* bl = (const LAS float*)(lds + BOFF) + (((w >> 1) & 1) * 15 + dr) * 31 + 15 - c;
#pragma unroll
                for (int kb = 0; kb < 2; ++kb) {
#pragma unroll
                    for (int i = 0; i < 16; ++i) {
                        const int jc = 32 * kb + crow(i, h); const bool ok = (unsigned)(jc - cs) < 16u;
                        const float bias = bl[ok ? jc : c];
                        sacc[kb][i] = ok ? sacc[kb][i] + bias : -1e30f;
                        if ((i & 7) == 7) asm volatile("" ::: "memory");
                    }
                }
            }
            float mx = sacc[0][0];
#pragma unroll
            for (int kb = 0; kb < 2; ++kb)
#pragma unroll
                for (int i = 0; i < 16; ++i) mx = fmaxf(mx, sacc[kb][i]);
            mx = fmaxf(mx, __shfl_xor(mx, 32));
            if (!__all(mx <= 8.0f)) {
                const float d = fmaxf(mx, 0.f), alpha = __builtin_amdgcn_exp2f(-d);
                mrun += d; lrun *= alpha;
#pragma unroll
                for (int vb = 0; vb < NVB; ++vb)
#pragma unroll
                    for (int i = 0; i < 16; ++i) oacc[vb][i] *= alpha;
#pragma unroll
                for (int kb = 0; kb < 2; ++kb)
#pragma unroll
                    for (int i = 0; i < 16; ++i) sacc[kb][i] -= d;
            }
            f32x2 sum2 = {0.f, 0.f};
#pragma unroll
            for (int kb = 0; kb < 2; ++kb)
#pragma unroll
                for (int i = 0; i < 16; i += 2) {
                    f32x2 pp; pp.x = __builtin_amdgcn_exp2f(sacc[kb][i]); pp.y = __builtin_amdgcn_exp2f(sacc[kb][i + 1]);
                    sacc[kb][i] = pp.x; sacc[kb][i + 1] = pp.y; sum2 += pp;
                }
            float sum = sum2.x + sum2.y;
            asm volatile("" : "+v"(sum));
            lrun += sum;
            bf16x8 pf[4];
#pragma unroll
            for (int t = 0; t < 4; ++t) {
                const int kb = t >> 1, o = 8 * (t & 1);
                u32x4 pw; pw.x = pk2(sacc[kb][o], sacc[kb][o + 1]); pw.y = pk2(sacc[kb][o + 2], sacc[kb][o + 3]); pw.z = pk2(sacc[kb][o + 4], sacc[kb][o + 5]); pw.w = pk2(sacc[kb][o + 6], sacc[kb][o + 7]);
                pf[t] = __builtin_bit_cast(bf16x8, pw);
            }
            {
                const int i16 = ln_ & 15, q4 = i16 >> 2, p4 = i16 & 3, g1 = (ln_ >> 4) & 1;
                LAS unsigned char* vbase = lds + VOFF + (4 * h + q4) * VSTR + (kc0 + 16 * g1) * 2 + 8 * p4;
#pragma unroll
                for (int t = 0; t < 4; ++t) {
#pragma unroll
                    for (int vb = 0; vb < NVB; ++vb) {
                        const s16x4 lo = __builtin_amdgcn_ds_read_tr16_b64_v4i16((LAS s16x4*)(vbase + (16 * t) * VSTR + 64 * vb));
                        const s16x4 hi = __builtin_amdgcn_ds_read_tr16_b64_v4i16((LAS s16x4*)(vbase + (16 * t + 8) * VSTR + 64 * vb));
                        const bf16x8 va = __builtin_shufflevector(lo, hi, 0, 1, 2, 3, 4, 5, 6, 7);
                        oacc[vb] = __builtin_amdgcn_mfma_f32_32x32x16_bf16(va, pf[t], oacc[vb], 0, 0, 0);
                    }
                    asm volatile("" ::: "memory");
                }
            }
            }
        }
#undef ATT_LOAD_TILE
        {
            lrun += __shfl_xor(lrun, 32);
            const float inv = 1.0f / lrun;
            bf16_t* op = a.O + (rowb + qpos) * 1024 + head * DV + 4 * h;
#pragma unroll
            for (int vb = 0; vb < NVB; ++vb)
#pragma unroll
                for (int g = 0; g < 4; ++g) {
                    u32x2 wv; wv.x = pk2(oacc[vb][4 * g] * inv, oacc[vb][4 * g + 1] * inv); wv.y = pk2(oacc[vb][4 * g + 2] * inv, oacc[vb][4 * g + 3] * inv);
                    *(u32x2*)(op + 32 * vb + 8 * g) = wv;
                }
        }
    }
    __syncthreads();
}

DI void attn_phase16(LAS unsigned char* lds, const AttnArgs a, int wv, bool with_ctx) {
    constexpr int KSTR = 288, VSTR = 288, VOFF = 64 * KSTR;
    constexpr int KCH = 16, VCH = 16, NKC = 2, NVC = 2;
    constexpr float QS = 0.08838834764831845f * LOG2E;
    const int tid = tidx(wv), w = __builtin_amdgcn_readfirstlane(tid >> 6);
    const int nunits = with_ctx ? 544 : 512;
    for (int it_ = bidx(); it_ < nunits; it_ += gridDim.x) {
        int u = it_;
        if (gridDim.x == 256 && it_ < 512) u = (((it_ >> 8) * 8 + (it_ & 7)) * 32) + ((it_ >> 3) & 31);
        int tu_ = tid; asm volatile("" : "+v"(tu_));
        const int lane = tu_ & 63, c = lane & 15, g = lane >> 4;
        int b, head, q0, ntiles, kbase0;
        if (u < 512) { b = u >> 7; head = (u >> 4) & 7; q0 = (u & 15) * 256 + 32 * w; ntiles = 68; kbase0 = 0; }
        else { const int v = u - 512; b = v >> 3; head = v & 7; q0 = 4096 + 32 * w; ntiles = 4; kbase0 = 4096; }
        const int kvh = head >> 2;
        const size_t rowb = (size_t)b * TPB;
        const bool lat = q0 < 4096;
        bf16x8 qf[2][4];
#pragma unroll
        for (int qb = 0; qb < 2; ++qb) {
            const int qpos = q0 + 16 * qb + c;
            const bf16_t* qp = a.Q + (rowb + qpos) * 1024 + head * 128 + 8 * g;
            u32x4 qraw[4];
#pragma unroll
            for (int s = 0; s < 4; ++s) qraw[s] = *(const u32x4*)(qp + 32 * s);
            float ss = 0.f;
#pragma unroll
            for (int s = 0; s < 4; ++s) { float f[8]; unpack8(qraw[s], f);
#pragma unroll
                for (int e = 0; e < 8; ++e) ss += f[e] * f[e]; }
            ss += __shfl_xor(ss, 16); ss += __shfl_xor(ss, 32);
            const float rstd = rsqrtf(ss * (1.0f / 128.0f) + 1e-6f) * QS;
            const int pr = qpos >> 6, pc = qpos & 63;
#pragma unroll
            for (int gg = 0; gg < 2; ++gg) {
                const int s0 = 2 * gg, s1 = s0 + 1, pos = gg ? pc : pr;
                float t1[8], t2[8], o1[8], o2[8]; unpack8(qraw[s0], t1); unpack8(qraw[s1], t2);
                const float* g1 = a.gain + 32 * s0 + 8 * g; const float* g2 = a.gain + 32 * s1 + 8 * g;
#pragma unroll
                for (int e = 0; e < 8; ++e) {
                    f32x2 cs = a.rope[pos * 32 + 8 * g + e]; if (!lat) { cs.x = 1.f; cs.y = 0.f; }
                    const float x1 = t1[e] * rstd * g1[e], x2 = t2[e] * rstd * g2[e];
                    o1[e] = x1 * cs.x - x2 * cs.y; o2[e] = x2 * cs.x + x1 * cs.y;
                }
                qraw[s0] = pack8(o1); qraw[s1] = pack8(o2);
                asm volatile("" ::: "memory");
            }
#pragma unroll
            for (int s = 0; s < 4; ++s) qf[qb][s] = __builtin_bit_cast(bf16x8, qraw[s]);
        }
        __syncthreads();
        f32x4 oacc[2][8];
#pragma unroll
        for (int qb = 0; qb < 2; ++qb)
#pragma unroll
            for (int vb = 0; vb < 8; ++vb) oacc[qb][vb] = (f32x4){0.f, 0.f, 0.f, 0.f};
        float mrun[2] = {0.f, 0.f}, lrun[2] = {0.f, 0.f};
        u32x4 kreg[NKC], vreg[NVC];
#define A16_LOAD(kp) do { \
        _Pragma("unroll") for (int i_ = 0; i_ < NKC; ++i_) { const int ci = tl_ + 512 * i_, kr = ci / KCH, cc = ci - kr * KCH; kreg[i_] = *(const u32x4*)(a.K + (rowb + (kp) + kr) * 256 + kvh * 128 + cc * 8); } \
        _Pragma("unroll") for (int i_ = 0; i_ < NVC; ++i_) { const int ci = tl_ + 512 * i_, kr = ci / VCH, cc = ci - kr * VCH; vreg[i_] = *(const u32x4*)(a.V + (rowb + (kp) + kr) * 256 + kvh * 128 + cc * 8); } } while (0)
        { int tl_ = tid; asm volatile("" : "+v"(tl_)); A16_LOAD(kbase0); }
        for (int j = 0; j < ntiles; ++j) {
            int tl_ = tid; asm volatile("" : "+v"(tl_));
            const int ln_ = tl_ & 63, c = ln_ & 15, g = ln_ >> 4;
            __syncthreads();
#pragma unroll
            for (int i_ = 0; i_ < NKC; ++i_) { const int ci = tl_ + 512 * i_, kr = ci / KCH, cc = ci - kr * KCH; *(LAS u32x4*)(lds + kr * KSTR + cc * 16) = kreg[i_]; }
#pragma unroll
            for (int i_ = 0; i_ < NVC; ++i_) { const int ci = tl_ + 512 * i_, kr = ci / VCH, cc = ci - kr * VCH; *(LAS u32x4*)(lds + VOFF + kr * VSTR + cc * 16) = vreg[i_]; }
            __syncthreads();
            if (j + 1 < ntiles) A16_LOAD(kbase0 + 64 * (j + 1));
            f32x4 sacc[2][4];
#pragma unroll
            for (int qb = 0; qb < 2; ++qb)
#pragma unroll
                for (int kb = 0; kb < 4; ++kb) { const float nm = -mrun[qb]; sacc[qb][kb] = (f32x4){nm, nm, nm, nm}; }
            const LAS unsigned char* kbase = lds + c * KSTR + 16 * g;
#pragma unroll
            for (int s = 0; s < 4; ++s) {
#pragma unroll
                for (int kb = 0; kb < 4; ++kb) {
                    const bf16x8 kf = *(const LAS bf16x8*)(kbase + 16 * kb * KSTR + 64 * s);
                    sacc[0][kb] = __builtin_amdgcn_mfma_f32_16x16x32_bf16(kf, qf[0][s], sacc[0][kb], 0, 0, 0);
                    sacc[1][kb] = __builtin_amdgcn_mfma_f32_16x16x32_bf16(kf, qf[1][s], sacc[1][kb], 0, 0, 0);
                }
                if (s & 1) asm volatile("" ::: "memory");
            }
            float mx[2];
#pragma unroll
            for (int qb = 0; qb < 2; ++qb) {
                float m_ = sacc[qb][0][0];
#pragma unroll
                for (int kb = 0; kb < 4; ++kb)
#pragma unroll
                    for (int jj = 0; jj < 4; ++jj) m_ = fmaxf(m_, sacc[qb][kb][jj]);
                m_ = fmaxf(m_, __shfl_xor(m_, 16)); m_ = fmaxf(m_, __shfl_xor(m_, 32));
                mx[qb] = m_;
            }
            if (!__all(fmaxf(mx[0], mx[1]) <= 8.0f)) {
#pragma unroll
                for (int qb = 0; qb < 2; ++qb) {
                    const float d = fmaxf(mx[qb], 0.f), alpha = __builtin_amdgcn_exp2f(-d);
                    mrun[qb] += d; lrun[qb] *= alpha;
#pragma unroll
                    for (int vb = 0; vb < 8; ++vb) oacc[qb][vb] *= alpha;
#pragma unroll
                    for (int kb = 0; kb < 4; ++kb) sacc[qb][kb] -= d;
                }
            }
            bf16x8 pf[2][2];
#pragma unroll
            for (int qb = 0; qb < 2; ++qb) {
                float sum = 0.f;
#pragma unroll
                for (int kb = 0; kb < 4; ++kb)
#pragma unroll
                    for (int jj = 0; jj < 4; ++jj) { const float pp = __builtin_amdgcn_exp2f(sacc[qb][kb][jj]); sacc[qb][kb][jj] = pp; sum += pp; }
                asm volatile("" : "+v"(sum));
                lrun[qb] += sum;
#pragma unroll
                for (int t = 0; t < 2; ++t) {
                    u32x4 pw; pw.x = pk2(sacc[qb][2 * t][0], sacc[qb][2 * t][1]); pw.y = pk2(sacc[qb][2 * t][2], sacc[qb][2 * t][3]);
                    pw.z = pk2(sacc[qb][2 * t + 1][0], sacc[qb][2 * t + 1][1]); pw.w = pk2(sacc[qb][2 * t + 1][2], sacc[qb][2 * t + 1][3]);
                    pf[qb][t] = __builtin_bit_cast(bf16x8, pw);
                }
            }
            {
                LAS unsigned char* vbase = lds + VOFF + (4 * g + (c >> 2)) * VSTR + 8 * (c & 3);
#pragma unroll
                for (int t = 0; t < 2; ++t) {
#pragma unroll
                    for (int vb = 0; vb < 8; ++vb) {
                        const s16x4 lo = __builtin_amdgcn_ds_read_tr16_b64_v4i16((LAS s16x4*)(vbase + (32 * t) * VSTR + 32 * vb));
                        const s16x4 hi = __builtin_amdgcn_ds_read_tr16_b64_v4i16((LAS s16x4*)(vbase + (32 * t + 16) * VSTR + 32 * vb));
                        const bf16x8 va = __builtin_shufflevector(lo, hi, 0, 1, 2, 3, 4, 5, 6, 7);
                        oacc[0][vb] = __builtin_amdgcn_mfma_f32_16x16x32_bf16(va, pf[0][t], oacc[0][vb], 0, 0, 0);
                        oacc[1][vb] = __builtin_amdgcn_mfma_f32_16x16x32_bf16(va, pf[1][t], oacc[1][vb], 0, 0, 0);
                        if (vb == 7) asm volatile("" ::: "memory");
                    }
                }
            }
        }
#undef A16_LOAD
#pragma unroll
        for (int qb = 0; qb < 2; ++qb) {
            float l_ = lrun[qb]; l_ += __shfl_xor(l_, 16); l_ += __shfl_xor(l_, 32);
            const float inv = 1.0f / l_;
            bf16_t* op = a.O + (rowb + q0 + 16 * qb + c) * 1024 + head * 128 + 4 * g;
#pragma unroll
            for (int vb = 0; vb < 8; ++vb) {
                u32x2 w2; w2.x = pk2(oacc[qb][vb][0] * inv, oacc[qb][vb][1] * inv); w2.y = pk2(oacc[qb][vb][2] * inv, oacc[qb][vb][3] * inv);
                *(u32x2*)(op + 16 * vb) = w2;
            }
        }
    }
    __syncthreads();
}

DI float* xrow_ptr(float* xlat, float* xctx, int m) { const int b = m / TPB, pos = m - b * TPB; return pos < 4096 ? xlat + ((size_t)b * 4096 + pos) * DM : xctx + ((size_t)b * 256 + (pos - 4096)) * DM; }
DI int modrow(int m) { const int b = m / TPB, pos = m - b * TPB; return pos < 4096 ? b : 4; }

struct RowPar { f32x4 G[4], B[4], GT[4], SH[4], SC[4]; };
template <bool LN> DI void rows_load(kaptr p, int b, int pos, int lane, f32x4 (&v)[4], int ctx_ks, const float* gate, const bf16_t* Y, bool x_in, const RowPar& P) {
    const float* src;
    if (!LN || x_in) src = pos < 4096 ? KIN(p, 0) + ((size_t)b * 4096 + pos) * DM : KIN(p, 2) + ((size_t)b * 256 + (pos - 4096)) * DM;
    else src = pos < 4096 ? KOUT(p) + ((size_t)b * 4096 + pos) * DM : (const float*)(KWS(p) + WS_XC) + ((size_t)b * 256 + (pos - 4096)) * DM;
    if (!LN) {
#pragma unroll
        for (int j = 0; j < 4; ++j) v[j] = *(const f32x4*)(src + 4 * lane + 256 * j);
    } else if (pos >= 4096) {
        const float* pp = (const float*)(KWS(p) + WS_PART) + ((size_t)b * 256 + (pos - 4096)) * DM + 4 * lane;
        const float* gp = gate + (size_t)4 * MODW + 4 * lane;
#pragma unroll
        for (int j = 0; j < 4; ++j) {
            f32x4 a = *(const f32x4*)(pp + 256 * j);
            for (int ks = 1; ks < ctx_ks; ++ks) a += *(const f32x4*)(pp + (size_t)ks * 1024 * DM + 256 * j);
            v[j] = *(const f32x4*)(src + 4 * lane + 256 * j) * ALPHA + *(const f32x4*)(gp + 256 * j) * a;
        }
    } else {
        const bf16_t* yp = Y + ((size_t)b * TPB + pos) * DM + 4 * lane;
#pragma unroll
        for (int j = 0; j < 4; ++j) {
            const u32x2 yw = *(const u32x2*)(yp + 256 * j);
            const f32x4 y = {bflo(yw.x), bfhi(yw.x), bflo(yw.y), bfhi(yw.y)};
            v[j] = *(const f32x4*)(src + 4 * lane + 256 * j) * ALPHA + P.GT[j] * y;
        }
    }
}
template <bool LN> DI void rows_finish(kaptr p, int b, int pos, int lane, f32x4 (&v)[4], const float* modp, bool write_h, const RowPar& P) {
    float* xr = pos < 4096 ? KOUT(p) + ((size_t)b * 4096 + pos) * DM : (float*)(KWS(p) + WS_XC) + ((size_t)b * 256 + (pos - 4096)) * DM;
    if (LN) {
        float s = 0.f;
#pragma unroll
        for (int j = 0; j < 4; ++j) s += (v[j].x + v[j].y) + (v[j].z + v[j].w);
        const float mean = wave_sum(s) * (1.0f / DM);
        float s2 = 0.f;
#pragma unroll
        for (int j = 0; j < 4; ++j) { v[j] = v[j] - mean; s2 += (v[j].x * v[j].x + v[j].y * v[j].y) + (v[j].z * v[j].z + v[j].w * v[j].w); }
        const float rstd = rsqrtf(wave_sum(s2) * (1.0f / DM) + 1e-5f);
#pragma unroll
        for (int j = 0; j < 4; ++j) v[j] = v[j] * rstd * P.G[j] + P.B[j];
#pragma unroll
        for (int j = 0; j < 4; ++j) *(f32x4*)(xr + 4 * lane + 256 * j) = v[j];
    }
    if (write_h) {
        bf16_t* H = (bf16_t*)(KWS(p) + WS_H) + ((size_t)b * TPB + pos) * DM;
        if (pos < 4096) {
#pragma unroll
            for (int j = 0; j < 4; ++j) { const f32x4 hh = v[j] * (P.SC[j] + 1.0f) + P.SH[j]; u32x2 w2; w2.x = pk2(hh.x, hh.y); w2.y = pk2(hh.z, hh.w); *(u32x2*)(H + 4 * lane + 256 * j) = w2; }
        } else {
            const float* mp = modp + (size_t)4 * MODW;
#pragma unroll
            for (int j = 0; j < 4; ++j) { const f32x4 sh = *(const f32x4*)(mp + 4 * lane + 256 * j), sc = *(const f32x4*)(mp + DM + 4 * lane + 256 * j);
                const f32x4 hh = v[j] * (sc + 1.0f) + sh; u32x2 w2; w2.x = pk2(hh.x, hh.y); w2.y = pk2(hh.z, hh.w); *(u32x2*)(H + 4 * lane + 256 * j) = w2; }
        }
    }
}
template <bool LN> DI void rows_phase(kaptr p, int wv, const float* lng, const float* lnb, const float* modp, bool write_h, int ctx_ks = 0, const float* gate = nullptr, const bf16_t* Y = nullptr, bool x_in = false) {
    const int lane = tidx(wv) & 63, gw = bidx() * 8 + (tidx(wv) >> 6), NW4 = (gridDim.x * 8) >> 2;
    const int b = gw & 3, w4 = gw >> 2;
    RowPar P;
#pragma unroll
    for (int j = 0; j < 4; ++j) {
        const f32x4 z4 = {0.f, 0.f, 0.f, 0.f};
        P.G[j] = LN ? *(const f32x4*)(lng + 4 * lane + 256 * j) : z4; P.B[j] = LN ? *(const f32x4*)(lnb + 4 * lane + 256 * j) : z4;
        P.GT[j] = LN ? *(const f32x4*)(gate + (size_t)b * MODW + 4 * lane + 256 * j) : z4;
        P.SH[j] = write_h ? *(const f32x4*)(modp + (size_t)b * MODW + 4 * lane + 256 * j) : z4; P.SC[j] = write_h ? *(const f32x4*)(modp + (size_t)b * MODW + DM + 4 * lane + 256 * j) : z4;
    }
    const int limit = ctx_ks < 0 ? SEQ : TPB;
    for (int pos = w4; pos < limit; pos += 4 * NW4) {
        const int pos2 = pos + NW4, pos3 = pos + 2 * NW4, pos4 = pos + 3 * NW4;
        const bool h2 = pos2 < limit, h3 = pos3 < limit, h4 = pos4 < limit;
        f32x4 va[4], vb[4], vc[4], vd[4];
        rows_load<LN>(p, b, pos, lane, va, ctx_ks, gate, Y, x_in, P);
        if (h2) rows_load<LN>(p, b, pos2, lane, vb, ctx_ks, gate, Y, x_in, P);
        if (h3) rows_load<LN>(p, b, pos3, lane, vc, ctx_ks, gate, Y, x_in, P);
        if (h4) rows_load<LN>(p, b, pos4, lane, vd, ctx_ks, gate, Y, x_in, P);
        rows_finish<LN>(p, b, pos, lane, va, modp, write_h, P);
        if (h2) rows_finish<LN>(p, b, pos2, lane, vb, modp, write_h, P);
        if (h3) rows_finish<LN>(p, b, pos3, lane, vc, modp, write_h, P);
        if (h4) rows_finish<LN>(p, b, pos4, lane, vd, modp, write_h, P);
    }
}

DI void kpost_a(kaptr p, int wv, const float* kgain) {
    bf16_t* K = (bf16_t*)(KWS(p) + WS_AK); const f32x2* rope = (const f32x2*)(KWS(p) + WS_ROPEA);
    const int lane = tidx(wv) & 63, j16 = lane & 15, sub = lane >> 4, gw = bidx() * 8 + (tidx(wv) >> 6), NGW = gridDim.x * 8;
    for (int it = gw; it < MROWS * 2 / 4; it += NGW) {
        const int item = it * 4 + sub, m = item >> 1, kvh = item & 1;
        const int b = m / TPB, pos = m - b * TPB; const bool lat = pos < 4096;
        unsigned* kp = (unsigned*)(K + (size_t)m * 256 + kvh * 128) + j16;
        float v[4][2]; float ss = 0.f;
#pragma unroll
        for (int k = 0; k < 4; ++k) { const unsigned wv = kp[16 * k]; v[k][0] = bflo(wv); v[k][1] = bfhi(wv); ss += v[k][0] * v[k][0] + v[k][1] * v[k][1]; }
        ss += __shfl_xor(ss, 1); ss += __shfl_xor(ss, 2); ss += __shfl_xor(ss, 4); ss += __shfl_xor(ss, 8);
        const float rstd = rsqrtf(ss * (1.0f / 128.0f) + 1e-6f);
#pragma unroll
        for (int k = 0; k < 4; ++k) { v[k][0] *= rstd * kgain[32 * k + 2 * j16]; v[k][1] *= rstd * kgain[32 * k + 2 * j16 + 1]; }
        if (lat) {
            const int pr = pos >> 6, pc = pos & 63;
#pragma unroll
            for (int g = 0; g < 2; ++g)
#pragma unroll
                for (int e = 0; e < 2; ++e) {
                    const f32x2 cs = rope[(g ? pc : pr) * 32 + 2 * j16 + e];
                    const float t1 = v[2 * g][e], t2 = v[2 * g + 1][e];
                    v[2 * g][e] = t1 * cs.x - t2 * cs.y; v[2 * g + 1][e] = t2 * cs.x + t1 * cs.y;
                }
        }
#pragma unroll
        for (int k = 0; k < 4; ++k) kp[16 * k] = pk2(v[k][0], v[k][1]);
    }
}
DI void post_c(kaptr p, int wv, const float* qg, const float* kvg) {
    bf16_t* QL = (bf16_t*)(KWS(p) + WS_CQL); bf16_t* KVL = (bf16_t*)(KWS(p) + WS_CKVL); bf16_t* KR = (bf16_t*)(KWS(p) + WS_CKR); const f32x2* rope = (const f32x2*)(KWS(p) + WS_ROPEC);
    const int lane = tidx(wv) & 63, gw = bidx() * 8 + (tidx(wv) >> 6), NGW = gridDim.x * 8;
    for (int m = gw; m < MROWS; m += NGW) {
        const int b = m / TPB, pos = m - b * TPB;
        {   unsigned* qp = (unsigned*)(QL + (size_t)m * 384) + lane; float v[3][2]; float ss = 0.f;
#pragma unroll
            for (int k = 0; k < 3; ++k) { const unsigned wv = qp[64 * k]; v[k][0] = bflo(wv); v[k][1] = bfhi(wv); ss += v[k][0] * v[k][0] + v[k][1] * v[k][1]; }
            const float rstd = rsqrtf(wave_sum(ss) * (1.0f / 384.0f) + 1e-6f);
#pragma unroll
            for (int k = 0; k < 3; ++k) qp[64 * k] = pk2(v[k][0] * rstd * qg[128 * k + 2 * lane], v[k][1] * rstd * qg[128 * k + 2 * lane + 1]); }
        {   unsigned* kp = (unsigned*)(KVL + (size_t)m * 256) + lane; float v[2][2]; float ss = 0.f;
#pragma unroll
            for (int k = 0; k < 2; ++k) { const unsigned wv = kp[64 * k]; v[k][0] = bflo(wv); v[k][1] = bfhi(wv); ss += v[k][0] * v[k][0] + v[k][1] * v[k][1]; }
            const float rstd = rsqrtf(wave_sum(ss) * (1.0f / 256.0f) + 1e-6f);
#pragma unroll
            for (int k = 0; k < 2; ++k) kp[64 * k] = pk2(v[k][0] * rstd * kvg[128 * k + 2 * lane], v[k][1] * rstd * kvg[128 * k + 2 * lane + 1]); }
        if (pos < 4096 && lane < 32) {
            const int g = lane >> 4, i = lane & 15; bf16_t* kr = KR + (size_t)m * 64 + 32 * g + i;
            const f32x2 cs = rope[(g ? (pos & 63) : (pos >> 6)) * 16 + i];
            const float t1 = bflo((unsigned)kr[0]), t2 = bflo((unsigned)kr[16]);
            kr[0] = (bf16_t)(pk2(t1 * cs.x - t2 * cs.y, 0.f) & 0xffffu); kr[16] = (bf16_t)(pk2(t2 * cs.x + t1 * cs.y, 0.f) & 0xffffu);
        }
    }
}

struct WJob { int in_idx, src_off, K, N, kind, pad; size_t dst; };
#define WJ_FFN(l) {8, (l) * DM * DFF, DM, DFF, 1, 0, WS_WGU(l)}, {9, (l) * DM * DFF, DM, DFF, 2, 0, WS_WGU(l)}, {10, (l) * DFF * DM, DFF, DM, 0, 0, WS_WD(l)}
__constant__ WJob kJobs[22] = {
    WJ_FFN(0), WJ_FFN(1), WJ_FFN(2), WJ_FFN(3),
    {11, 0, DM, 1536, 0, 0, WS_WA_QKV(0)}, {14, 0, DM, DM, 0, 0, WS_WA_O(0)}, {11, DM * 1536, DM, 1536, 0, 0, WS_WA_QKV(1)}, {14, DM * DM, DM, DM, 0, 0, WS_WA_O(1)},
    {15, 0, DM, 3072, 0, 0, WS_WB_QKV}, {17, 0, DM, DM, 0, 0, WS_WB_O},
    {18, 0, DM, 704, 0, 0, WS_WC_DQKV}, {21, 0, 384, 1536, 0, 0, WS_WC_UQ}, {22, 0, 256, 2048, 0, 0, WS_WC_UKV}, {23, 0, DM, DM, 0, 0, WS_WC_O}};
constexpr int NMOD_ITEMS = DEPTH * (MODW / 64);

DI void prologue_a(kaptr p, LAS unsigned char* lds, int wv) {
    const int tid = tidx(wv), lane = tid & 63, w = tid >> 6;
    LAS float* cond = (LAS float*)(lds);
    LAS float* red = (LAS float*)(lds + 20480);
    if (bidx() < NMOD_ITEMS) {
        for (int t = tid; t < 5 * DM; t += 512) { const float cv = t < 4 * DM ? KIN(p, 1)[t] : KIN(p, 3)[t - 4 * DM]; cond[t] = cv / (1.0f + __expf(-cv)); }
    }
    for (int it = bidx(); it < NMOD_ITEMS; it += gridDim.x) {
        __syncthreads();
        const int layer = it / (MODW / 64), n0 = (it - layer * (MODW / 64)) * 64;
        const float* wp = KIN(p, 4) + (size_t)layer * DM * MODW + (size_t)(128 * w) * MODW + n0 + lane;
        float acc[5] = {0.f, 0.f, 0.f, 0.f, 0.f};
#pragma unroll 16
        for (int k = 0; k < 128; ++k) { const float wv1 = wp[(size_t)k * MODW];
#pragma unroll
            for (int rI = 0; rI < 5; ++rI) acc[rI] += cond[rI * DM + 128 * w + k] * wv1; }
#pragma unroll
        for (int rI = 0; rI < 5; ++rI) red[(w * 5 + rI) * 64 + lane] = acc[rI];
        __syncthreads();
        if (tid < 320) { const int rI = tid >> 6; float sm = KIN(p, 5)[(size_t)layer * MODW + n0 + lane];
#pragma unroll
            for (int ww = 0; ww < 8; ++ww) sm += red[(ww * 5 + rI) * 64 + lane];
            ((float*)(KWS(p) + WS_MOD))[((size_t)layer * 5 + rI) * MODW + n0 + lane] = sm; }
    }
    {
        int nitem_total = 0;
        for (int j = 0; j < 22; ++j) nitem_total += (kJobs[j].K / 64) * (kJobs[j].N / 32);
        LAS float* scr = (LAS float*)(lds + 65536 + w * 8448);
        const int kr = lane >> 3, c4 = lane & 7, nrow = lane >> 1, hf = lane & 1;
        for (int it = bidx() * 8 + w; it < nitem_total; it += gridDim.x * 8) {
            int t = it, j = 0;
            for (; j < 21; ++j) { const int nt = (kJobs[j].K / 64) * (kJobs[j].N / 32); if (t < nt) break; t -= nt; }
            const WJob jb = kJobs[j];
            const int nblk = jb.N / 32, kb = t / nblk, nb = t - kb * nblk, k0 = 64 * kb, n0 = 32 * nb;
            const float* W = KIN(p, jb.in_idx) + jb.src_off + (size_t)(k0 + kr) * jb.N + n0 + 4 * c4;
            f32x4 v4[8];
#pragma unroll
            for (int i = 0; i < 8; ++i) v4[i] = *(const f32x4*)(W + (size_t)(8 * i) * jb.N);
#pragma unroll
            for (int i = 0; i < 8; ++i) { const int kk = 8 * i + kr; scr[(4 * c4 + 0) * 65 + kk] = v4[i].x; scr[(4 * c4 + 1) * 65 + kk] = v4[i].y; scr[(4 * c4 + 2) * 65 + kk] = v4[i].z; scr[(4 * c4 + 3) * 65 + kk] = v4[i].w; }
            asm volatile("s_waitcnt lgkmcnt(0)" ::: "memory");
            const int nn = n0 + nrow; const int drow = jb.kind == 0 ? nn : 256 * (nn >> 7) + (nn & 127) + (jb.kind == 2 ? 128 : 0);
            bf16_t* dp = (bf16_t*)(KWS(p) + jb.dst) + (size_t)drow * jb.K + k0 + 32 * hf;
#pragma unroll
            for (int q = 0; q < 4; ++q) {
                const LAS float* sp = scr + nrow * 65 + 32 * hf + 8 * q;
                u32x4 o; o.x = pk2(sp[0], sp[1]); o.y = pk2(sp[2], sp[3]); o.z = pk2(sp[4], sp[5]); o.w = pk2(sp[6], sp[7]);
                *(u32x4*)(dp + 8 * q) = o;
            }
            asm volatile("s_waitcnt lgkmcnt(0)" ::: "memory");
        }
    }
    const int gt = bidx() * 512 + tid, NGT = gridDim.x * 512;
    for (int t = gt; t < 64 * 32; t += NGT) { const int pos = t >> 5, i = t & 31; const float f = exp2f(-(float)(2 * i) * (1.0f / 64.0f) * 13.287712379549449f); float sn, cs; sincosf((float)pos * f, &sn, &cs); ((f32x2*)(KWS(p) + WS_ROPEA))[t] = (f32x2){cs, sn}; }
    for (int t = gt; t < 64 * 16; t += NGT) { const int pos = t >> 4, i = t & 15; const float f = exp2f(-(float)(2 * i) * (1.0f / 32.0f) * 13.287712379549449f); float sn, cs; sincosf((float)pos * f, &sn, &cs); ((f32x2*)(KWS(p) + WS_ROPEC))[t] = (f32x2){cs, sn}; }
    for (int t = gt; t < 64 * DM / 8; t += NGT) ((u32x4*)((bf16_t*)(KWS(p) + WS_WC_DQKV) + (size_t)704 * DM))[t] = (u32x4){0u, 0u, 0u, 0u};
    __syncthreads();
}

constexpr int NPHASES = 2 + 9 * DEPTH;
#if defined(PROBE_MASK)
#ifndef PROBE_LAYER
#define PROBE_LAYER -1
#endif
#define PROBE_SEL(k) ((k) < 2 ? ((PROBE_MASK >> (9 + (k))) & 1) : (((PROBE_MASK >> (((k) - 2) % 9)) & 1) && (PROBE_LAYER < 0 || ((k) - 2) / 9 == PROBE_LAYER)))
#define TSTART(k) if (PROBE_SEL(k)) tq0 = __builtin_amdgcn_s_memrealtime();
#define TSTOP(k) if (PROBE_SEL(k)) tacc += __builtin_amdgcn_s_memrealtime() - tq0;
#else
#define TSTART(k)
#define TSTOP(k)
#endif
#define PHASE_BEGIN(k) if (lo <= (k) && (k) < hi) { TSTART(k) kaptr p = (kaptr)__builtin_amdgcn_kernarg_segment_ptr(); asm volatile("" : "+s"(p)); unsigned char* ws = KWS(p); (void)ws;
#if defined(PROBE_SEAM2)
#define PHASE_END(k) if ((k) + 1 < hi) { gbar((unsigned*)(KWS(p) + WS_BAR), (LAS unsigned*)(lds + LDS_BYTES - 64), wv); gbar((unsigned*)(KWS(p) + WS_BAR), (LAS unsigned*)(lds + LDS_BYTES - 64), wv); } TSTOP(k) }
#else
#define PHASE_END(k) if ((k) + 1 < hi) gbar((unsigned*)(KWS(p) + WS_BAR), (LAS unsigned*)(lds + LDS_BYTES - 64), wv); TSTOP(k) }
#endif
#define XB_XCNT(j)  (256  + 64 * (j))
#define XB_XSUB(j)  (1280 + 64 * (j))
#define XB_XGEN(j)  (2304 + 64 * (j))
#define XB_TOP      3328
#define XB_TOPGEN   3392
#define XCD_BAR_WORDS 3456
DI unsigned xb_ld(unsigned* p_) { return __hip_atomic_load(p_, __ATOMIC_RELAXED, __HIP_MEMORY_SCOPE_AGENT); }
DI unsigned xb_add(unsigned* p_, unsigned v) { return __hip_atomic_fetch_add(p_, v, __ATOMIC_RELAXED, __HIP_MEMORY_SCOPE_AGENT); }
DI unsigned xb_xcc_id() { return (unsigned)__builtin_amdgcn_s_getreg((3 << 11) | 20) & 0xFu; }
DI void gbar(unsigned* bar, LAS unsigned* st, int wv) {
    asm volatile("s_waitcnt vmcnt(0)" ::: "memory");
    __syncthreads();
    if (tidx(wv) == 0) {
        __builtin_amdgcn_s_waitcnt(0);
        const unsigned x = xb_xcc_id();
        unsigned nloc = st[0], nx = st[1];
        if (nloc == 0u) {
            const unsigned G = gridDim.x;
            for (;;) { unsigned sum = 0u, cnt = 0u, mine = 0u;
#pragma unroll
                for (unsigned j = 0; j < 16; ++j) { const unsigned c = xb_ld(&bar[XB_XCNT(j)]); sum += c; cnt += (c > 0u) ? 1u : 0u; mine = (j == x) ? c : mine; }
                if (sum == G) { nloc = mine; nx = cnt; break; }
                __builtin_amdgcn_s_sleep(1); }
            st[0] = nloc; st[1] = nx;
        }
        const unsigned old = xb_add(&bar[XB_XSUB(x)], 1u);
        const unsigned gen = old / nloc;
        if (old + 1u == (gen + 1u) * nloc) {
            __builtin_amdgcn_fence(__ATOMIC_RELEASE, "agent");
            asm volatile("s_waitcnt vmcnt(0)" ::: "memory");
            const unsigned og = xb_add(&bar[XB_TOP], 1u);
            const unsigned tg = og / nx;
            if (og + 1u == (tg + 1u) * nx) xb_add(&bar[XB_TOPGEN], 1u);
            else while (xb_ld(&bar[XB_TOPGEN]) == tg) __builtin_amdgcn_s_sleep(1);
            __builtin_amdgcn_fence(__ATOMIC_ACQUIRE, "agent");
            xb_add(&bar[XB_XGEN(x)], 1u);
            asm volatile("s_waitcnt vmcnt(0)" ::: "memory");
        } else {
            while (xb_ld(&bar[XB_XGEN(x)]) == gen) __builtin_amdgcn_s_sleep(1);
            __builtin_amdgcn_fence(__ATOMIC_ACQUIRE, "agent");
            asm volatile("s_waitcnt vmcnt(0)" ::: "memory");
        }
    }
    __syncthreads();
}
template <int LAYER> DI void layer_phases(int lo, int hi, LAS unsigned char* lds, int wv, unsigned& nbar, unsigned long long& tacc) {
    unsigned long long tq0 = 0; (void)tq0;
    constexpr int kind = LAYER % 3, inst = LAYER / 3, P0 = 2 + 9 * LAYER; constexpr bool LASTL = LAYER == DEPTH - 1;
    constexpr size_t MODL = WS_MOD + (size_t)LAYER * 5 * MODW * 4;
    PHASE_BEGIN(P0 + 0)
        bf16_t* H = (bf16_t*)(ws + WS_H);
        if constexpr (kind == 0) { const EpiStore E = EpiStore::make((bf16_t*)(ws + WS_AQ), (bf16_t*)(ws + WS_AK), (bf16_t*)(ws + WS_AV), 1024, 1280, 1024, 256, 256, 1536);
            run_gemm(lds, wv, H, (const bf16_t*)(ws + WS_WA_QKV(inst)), MROWS, 1536, DM, E); }
        else if constexpr (kind == 1) { const EpiStore E = EpiStore::make((bf16_t*)(ws + WS_BQ), (bf16_t*)(ws + WS_BK), (bf16_t*)(ws + WS_BV), 1024, 2048, 1024, 1024, 1024, 3072);
            run_gemm(lds, wv, H, (const bf16_t*)(ws + WS_WB_QKV), MROWS, 3072, DM, E); }
        else { const EpiStore E = EpiStore::make((bf16_t*)(ws + WS_CQL), (bf16_t*)(ws + WS_CKVL), (bf16_t*)(ws + WS_CKR), 384, 640, 384, 256, 64, 704);
            run_gemm(lds, wv, H, (const bf16_t*)(ws + WS_WC_DQKV), MROWS, 768, DM, E); }
    PHASE_END(P0 + 0)
    if constexpr (kind == 0) { PHASE_BEGIN(P0 + 1) kpost_a(p, wv, KIN(p, 13) + inst * 128); PHASE_END(P0 + 1) }
    if constexpr (kind == 2) {
        PHASE_BEGIN(P0 + 1) post_c(p, wv, KIN(p, 19), KIN(p, 20)); PHASE_END(P0 + 1)
        PHASE_BEGIN(P0 + 2)
            { const EpiStore E = EpiStore::make((bf16_t*)(ws + WS_CQ), (bf16_t*)(ws + WS_CQ), (bf16_t*)(ws + WS_CQ), 0, 0, 1536, 1536, 1536, 1536);
              run_gemm(lds, wv, (const bf16_t*)(ws + WS_CQL), (const bf16_t*)(ws + WS_WC_UQ), MROWS, 1536, 384, E); }
            { const EpiStore E = EpiStore::make((bf16_t*)(ws + WS_CKV), (bf16_t*)(ws + WS_CKV), (bf16_t*)(ws + WS_CKV), 0, 0, 2048, 2048, 2048, 2048);
              run_gemm(lds, wv, (const bf16_t*)(ws + WS_CKVL), (const bf16_t*)(ws + WS_WC_UKV), MROWS, 2048, 256, E); }
        PHASE_END(P0 + 2)
    }
    PHASE_BEGIN(P0 + 3)
        bf16_t* H = (bf16_t*)(ws + WS_H);
#if defined(PROBE_ATT2)
        for (int rep_ = 0; rep_ < 2; ++rep_) { if (rep_) gbar((unsigned*)(ws + WS_BAR), (LAS unsigned*)(lds + LDS_BYTES - 64), wv);
#endif
        if constexpr (kind == 0) { const AttnArgs a{(const bf16_t*)(ws + WS_AQ), (const bf16_t*)(ws + WS_AK), (const bf16_t*)(ws + WS_AV), nullptr, H, KIN(p, 12) + inst * 128, nullptr, (const f32x2*)(ws + WS_ROPEA)}; attn_phase16(lds, a, wv, LAYER != DEPTH - 1); }
        else if constexpr (kind == 1) { const AttnArgs a{(const bf16_t*)(ws + WS_BQ), (const bf16_t*)(ws + WS_BK), (const bf16_t*)(ws + WS_BV), nullptr, H, nullptr, KIN(p, 16), nullptr}; attn_phase<1>(lds, a, wv, LAYER != DEPTH - 1); }
        else { const AttnArgs a{(const bf16_t*)(ws + WS_CQ), (const bf16_t*)(ws + WS_CKV), (const bf16_t*)(ws + WS_CKV), (const bf16_t*)(ws + WS_CKR), H, nullptr, nullptr, (const f32x2*)(ws + WS_ROPEC)}; attn_phase<2>(lds, a, wv, LAYER != DEPTH - 1); }
#if defined(PROBE_ATT2)
        }
#endif
    PHASE_END(P0 + 3)
    PHASE_BEGIN(P0 + 4)
        constexpr size_t WO = kind == 0 ? WS_WA_O(inst) : (kind == 1 ? WS_WB_O : WS_WC_O);
        const EpiResid E{(bf16_t*)(ws + WS_R), (float*)(ws + WS_PART)};
        run_gemm_lat(lds, wv, (const bf16_t*)(ws + WS_H), (const bf16_t*)(ws + WO), DM, DM, LASTL ? 0 : 4, E);
    PHASE_END(P0 + 4)
    PHASE_BEGIN(P0 + 5) rows_phase<true>(p, wv, KIN(p, 6) + (size_t)(LAYER * 2 + 0) * DM, KIN(p, 7) + (size_t)(LAYER * 2 + 0) * DM, (const float*)(ws + MODL) + 3 * DM, true, LASTL ? -1 : 4, (const float*)(ws + MODL) + 2 * DM, (const bf16_t*)(ws + WS_R), LAYER == 0); PHASE_END(P0 + 5)
    PHASE_BEGIN(P0 + 6) const EpiSwiGLU E{(bf16_t*)(ws + WS_ACT)};
#if defined(PROBE_UP2)
        run_gemm(lds, wv, (const bf16_t*)(ws + WS_H), (const bf16_t*)(ws + WS_WGU(LAYER)), MROWS, 2 * DFF, DM, E); gbar((unsigned*)(ws + WS_BAR), (LAS unsigned*)(lds + LDS_BYTES - 64), wv);
#endif
        if constexpr (LASTL) run_gemm_lat(lds, wv, (const bf16_t*)(ws + WS_H), (const bf16_t*)(ws + WS_WGU(LAYER)), 2 * DFF, DM, 0, E);
        else run_gemm(lds, wv, (const bf16_t*)(ws + WS_H), (const bf16_t*)(ws + WS_WGU(LAYER)), MROWS, 2 * DFF, DM, E);
    PHASE_END(P0 + 6)
    PHASE_BEGIN(P0 + 7) const EpiResid E{(bf16_t*)(ws + WS_H), (float*)(ws + WS_PART)};     run_gemm_lat(lds, wv, (const bf16_t*)(ws + WS_ACT), (const bf16_t*)(ws + WS_WD(LAYER)), DM, DFF, LASTL ? 0 : 11, E); PHASE_END(P0 + 7)
    PHASE_BEGIN(P0 + 8) constexpr bool last = LAYER == DEPTH - 1;
        rows_phase<true>(p, wv, KIN(p, 6) + (size_t)(LAYER * 2 + 1) * DM, KIN(p, 7) + (size_t)(LAYER * 2 + 1) * DM, (const float*)(ws + MODL) + (last ? 0 : 5 * MODW), !last, LASTL ? -1 : 11, (const float*)(ws + MODL) + 5 * DM, (const bf16_t*)(ws + WS_H)); PHASE_END(P0 + 8)
}
static bool phase_exists(int ph) {
    if (ph < 2) return true;
    const int layer = (ph - 2) / 9, step = (ph - 2) - layer * 9, kind = layer % 3;
    if (step == 1) return kind != 1;
    if (step == 2) return kind == 2;
    return true;
}

__global__ void __launch_bounds__(512, 2) mk_fwd(Params prm) {
    extern __shared__ __attribute__((aligned(16))) unsigned char lds_raw[];
    LAS unsigned char* lds = (LAS unsigned char*)lds_raw;
    const int wv = __builtin_amdgcn_readfirstlane((int)(threadIdx.x >> 6));
    const int lo = prm.ph_lo, hi = prm.ph_hi;
    unsigned nbar = 0; (void)nbar;
    if (threadIdx.x < 16) ((LAS unsigned*)(lds + LDS_BYTES - 64))[threadIdx.x] = 0u;
    if (threadIdx.x == 0 && hi - lo > 1) xb_add((unsigned*)(prm.ws + WS_BAR) + XB_XCNT(xb_xcc_id()), 1u);
    __syncthreads();
    unsigned long long tacc = 0, tq0 = 0; (void)tq0;
    if (lo <= 0 && 0 < hi) { TSTART(0) kaptr p = (kaptr)__builtin_amdgcn_kernarg_segment_ptr(); asm volatile("" : "+s"(p)); prologue_a(p, lds, wv);
        if (1 < hi) cg::this_grid().sync(); TSTOP(0) }
    PHASE_BEGIN(1) rows_phase<false>(p, wv, nullptr, nullptr, (const float*)(ws + WS_MOD), true); PHASE_END(1)
    layer_phases<0>(lo, hi, lds, wv, nbar, tacc);
    layer_phases<1>(lo, hi, lds, wv, nbar, tacc);
    layer_phases<2>(lo, hi, lds, wv, nbar, tacc);
    layer_phases<3>(lo, hi, lds, wv, nbar, tacc);
#if defined(PROBE_MASK)
    { const unsigned long long t1 = __builtin_amdgcn_s_memrealtime(); while (__builtin_amdgcn_s_memrealtime() - t1 < 4ull * tacc) __builtin_amdgcn_s_sleep(8); }
#endif
}

#ifndef MK_MULTI
#define MK_MULTI 0
#endif
extern "C" void kernel_launch(void* const* d_in, const int* in_sizes, int n_in, void* d_out, int out_size, void* d_ws, size_t ws_size, hipStream_t stream) {
    static int grid = 0;
    if (grid == 0) {
        if (n_in != 24 || out_size != NBATCH * SEQ * DM || ws_size < WS_END) { fprintf(stderr, "kernel_launch: unexpected shapes (n_in %d, out %d, ws %zu < %zu)\n", n_in, out_size, ws_size, (size_t)WS_END); grid = -1; return; }
        int dev = 0, cus = 0, per_cu = 0;
        hipGetDevice(&dev); hipDeviceGetAttribute(&cus, hipDeviceAttributeMultiprocessorCount, dev);
        if (hipFuncSetAttribute((const void*)mk_fwd, hipFuncAttributeMaxDynamicSharedMemorySize, LDS_BYTES) != hipSuccess) { fprintf(stderr, "kernel_launch: hipFuncSetAttribute failed\n"); grid = -1; return; }
        if (hipOccupancyMaxActiveBlocksPerMultiprocessor(&per_cu, (const void*)mk_fwd, 512, LDS_BYTES) != hipSuccess || per_cu < 1) { fprintf(stderr, "kernel_launch: occupancy query says %d\n", per_cu); per_cu = 1; }
        (void)hipGetLastError();
        grid = cus * per_cu;
    }
    if (grid < 0) return;
    Params p{};
    for (int i = 0; i < 24; ++i) p.in[i] = (const float*)d_in[i];
    p.out = (float*)d_out; p.ws = (unsigned char*)d_ws;
#if MK_MULTI
    for (int ph = 0; ph < NPHASES; ++ph) {
        if (!phase_exists(ph)) continue;
        p.ph_lo = ph; p.ph_hi = ph + 1;
        hipLaunchKernelGGL(mk_fwd, dim3(grid), dim3(512), LDS_BYTES, stream, p);
    }
#else
    p.ph_lo = 0; p.ph_hi = NPHASES;
    if (hipMemsetAsync((char*)d_ws + WS_BAR, 0, XCD_BAR_WORDS * 4, stream) != hipSuccess) { fprintf(stderr, "kernel_launch: memset of the barrier words failed\n"); return; }
    void* args[] = {&p};
    hipError_t e = hipLaunchCooperativeKernel((const void*)mk_fwd, dim3(grid), dim3(512), args, LDS_BYTES, stream);
    if (e != hipSuccess) fprintf(stderr, "cooperative launch failed: %s (grid %d)\n", hipGetErrorString(e), grid);
#endif
}
```

```cpp
#include <hip/hip_runtime.h>
#include <hip/hip_cooperative_groups.h>
#include <cstdio>
#include <cstdint>
namespace cg = cooperative_groups;
__device__ __forceinline__ int tidx(int wv) { int t = wv * 64 + (int)__builtin_amdgcn_mbcnt_hi(~0u, __builtin_amdgcn_mbcnt_lo(~0u, 0u)); asm volatile("" : "+v"(t)); return t; }
__device__ __forceinline__ int bidx() { int b = blockIdx.x; asm volatile("" : "+s"(b)); return b; }
namespace pg8 {
#define PG8_LAS __attribute__((address_space(3)))
typedef unsigned short bf16_t;
typedef short bf16x8 __attribute__((ext_vector_type(8)));
typedef float f32x4 __attribute__((ext_vector_type(4)));
typedef unsigned u32x4 __attribute__((ext_vector_type(4)));
constexpr int BM = 256, BK = 64, HALF = 128, HTB = HALF * BK * 2  , STAGE_BYTES = 8 * HTB, NXCD = 8, WGM = 16;

__host__ __device__ __forceinline__ int lds_byte(int r, int c) { const int st = (r >> 4) * 2 + (c >> 5), rr = r & 15, cc = c & 31, ob = rr * 64 + cc * 2; return st * 1024 + (ob ^ (((ob >> 9) & 1) << 5)); }
__host__ __device__ __forceinline__ void stage_rc(int b, int& R, int& C) { const int st = b / 1024, sb = b % 1024, swz = sb ^ (((sb >> 9) & 1) << 5); R = (st >> 1) * 16 + swz / 64; C = (st & 1) * 32 + (swz % 64) / 2; }
__host__ __device__ __forceinline__ int perm32(int rho) { const int n = rho >> 4, i = rho & 15; return 8 * (i >> 2) + 4 * n + (i & 3); }

struct Unit { int pm, pn, k0, nt, ks; };
struct Gemm { const bf16_t* A; const bf16_t* Bt; int M, N, K; };

struct StaticOrder {
    int nM, nN, nwg, G, c, ntk;
    __host__ __device__ void init(int M, int N, int G_, int c_) { nM = M / BM; nN = N / BM; nwg = nM * nN; G = G_; c = c_; }
    __host__ __device__ bool next(int i, Unit& u) const {
        const long L = (long)i * G + c; if (L >= nwg) return false;
        int wgid = (int)L; { const int q = nwg / NXCD, r = nwg % NXCD, xcd = wgid % NXCD, off = wgid / NXCD; wgid = (xcd < r ? xcd * (q + 1) : r * (q + 1) + (xcd - r) * q) + off; }
        const int nig = WGM * nN, gid = wgid / nig, fm = gid * WGM, gsz = (nM - fm) < WGM ? (nM - fm) : WGM;
        u.pm = fm + ((wgid % nig) % gsz); u.pn = (wgid % nig) / gsz; u.k0 = 0; u.nt = ntk; u.ks = -1; return true;
    }
    __device__ __forceinline__ void a_ready(const Unit&) const {}
    __device__ __forceinline__ void done(const Unit&) const {}
};
template <class Epi, class Sched, bool ALIGN_EPI = false, bool SP2 = false>
__device__ __forceinline__ void gemm_phase(PG8_LAS unsigned char* lds, const Gemm g, const Sched& S, const Epi& E, int wv) {
    const int tid = tidx(wv), wid = __builtin_amdgcn_readfirstlane(tid >> 6), lane = tid & 63, wr = wid >> 2, wc = wid & 3, fr = lane & 15, fq = lane >> 4;
    const int K = g.K;
    unsigned voffA[2], voffB[2];
#pragma unroll
    for (int i = 0; i < 2; ++i) { int R, C; stage_rc(tid * 16 + i * 8192, R, C); const int Rb = Epi::PERM ? ((R & ~31) + perm32(R & 31)) : R;
        voffA[i] = (unsigned)(R * K + C) * 2u; voffB[i] = (unsigned)(Rb * K + C) * 2u; }
    const size_t kstep = (size_t)(BK * 2);
    const size_t hstep = (size_t)HALF * K * 2;
    const size_t tstep = 2 * hstep;
    const unsigned ldsw = (unsigned)wid * 1024u;
    const int aoff = lds_byte(wr * 64 + fr, fq * 8), boff = lds_byte(wc * 32 + fr, fq * 8);
#define PG8_SA(b, h) (((b) * 2 + (h)) * HTB)
#define PG8_SB(b, h) ((4 + (b) * 2 + (h)) * HTB)
#define PG8_STAGE(bufoff, gbase, voff) do { _Pragma("unroll") for (int _i = 0; _i < 2; ++_i) \
        __builtin_amdgcn_global_load_lds((const unsigned*)((const char*)(gbase) + (voff)[_i]), (PG8_LAS unsigned*)(lds + (bufoff) + ldsw + _i * 8192), 16, 0, 0); } while (0)
#define PG8_LDA(dst, b, h) do { _Pragma("unroll") for (int m = 0; m < 4; ++m) _Pragma("unroll") for (int k = 0; k < 2; ++k) dst[m][k] = *(const PG8_LAS bf16x8*)(lds + PG8_SA(b, h) + aoff + m * 2048 + k * 1024); } while (0)
#define PG8_LDB(dst, b, h) do { _Pragma("unroll") for (int n = 0; n < 2; ++n) _Pragma("unroll") for (int k = 0; k < 2; ++k) dst[n][k] = *(const PG8_LAS bf16x8*)(lds + PG8_SB(b, h) + boff + n * 2048 + k * 1024); } while (0)
#define PG8_MMA(ai, bj, At, Bt) do { __builtin_amdgcn_s_setprio(1); _Pragma("unroll") for (int m = 0; m < 4; ++m) _Pragma("unroll") for (int n = 0; n < 2; ++n) _Pragma("unroll") for (int k = 0; k < 2; ++k) \
        acc[ai][bj][m][n] = __builtin_amdgcn_mfma_f32_16x16x32_bf16(Bt[n][k], At[m][k], acc[ai][bj][m][n], 0, 0, 0); __builtin_amdgcn_s_setprio(0); } while (0)
#define PG8_WAIT_V(n) asm volatile("s_waitcnt vmcnt(" #n ")" ::: "memory")
#define PG8_WAIT_L(n) asm volatile("s_waitcnt lgkmcnt(" #n ")" ::: "memory")
#define PG8_BAR __builtin_amdgcn_s_barrier()
#define PG8_SCHED __builtin_amdgcn_sched_barrier(0)
    Unit cur, nxt; int ui = 0;
    if (!S.next(0, cur)) return;
    f32x4 acc[2][2][4][2];
#pragma unroll
    for (int a = 0; a < 2; ++a)
#pragma unroll
        for (int b = 0; b < 2; ++b)
#pragma unroll
            for (int m = 0; m < 4; ++m)
#pragma unroll
                for (int n = 0; n < 2; ++n) acc[a][b][m][n] = (f32x4){0.f, 0.f, 0.f, 0.f};
    bf16x8 At[4][2], B0[2][2], B1[2][2];
    const char* cA = (const char*)g.A + (size_t)cur.pm * tstep + (size_t)cur.k0 * 2; const char* cB = (const char*)g.Bt + (size_t)cur.pn * tstep + (size_t)cur.k0 * 2;
    int nt = cur.nt;
    S.a_ready(cur);
    if constexpr (SP2) {
        PG8_STAGE(PG8_SB(0, 0), cB, voffB); PG8_STAGE(PG8_SB(0, 1), cB + hstep, voffB); PG8_STAGE(PG8_SA(0, 0), cA, voffA); PG8_STAGE(PG8_SA(0, 1), cA + hstep, voffA);
        if (wr == 1) PG8_BAR;
        PG8_WAIT_V(2); PG8_BAR;
        PG8_STAGE(PG8_SB(1, 0), cB + kstep, voffB); PG8_STAGE(PG8_SA(1, 0), cA + kstep, voffA); PG8_STAGE(PG8_SB(1, 1), cB + hstep + kstep, voffB);
        PG8_WAIT_V(6); PG8_BAR;
    } else {
        PG8_STAGE(PG8_SB(0, 0), cB, voffB); PG8_STAGE(PG8_SA(0, 0), cA, voffA); PG8_STAGE(PG8_SB(0, 1), cB + hstep, voffB); PG8_STAGE(PG8_SA(0, 1), cA + hstep, voffA);
        if (wr == 1) PG8_BAR;
        PG8_WAIT_V(4); PG8_BAR;
        PG8_STAGE(PG8_SB(1, 0), cB + kstep, voffB); PG8_STAGE(PG8_SA(1, 0), cA + kstep, voffA); PG8_STAGE(PG8_SB(1, 1), cB + hstep + kstep, voffB);
        PG8_WAIT_V(6); PG8_BAR;
    }
    for (;;) {
        const bool has_next = S.next(ui + 1, nxt);
        const char* nA = has_next ? (const char*)g.A + (size_t)nxt.pm * tstep + (size_t)nxt.k0 * 2 : cA; const char* nB = has_next ? (const char*)g.Bt + (size_t)nxt.pn * tstep + (size_t)nxt.k0 * 2 : cB;
        for (int t = 0; t < nt; t += 2) {
            const bool last = (t == nt - 2);
            const char* a1 = cA + (size_t)(t + 1) * kstep;
            const char* a2 = last ? nA : cA + (size_t)(t + 2) * kstep; const char* b2 = last ? nB : cB + (size_t)(t + 2) * kstep;
            const char* a3 = a2 + kstep; const char* b3 = b2 + kstep;
            if (last && has_next) S.a_ready(nxt);
            if constexpr (SP2) {
            PG8_LDB(B0, 0, 0); PG8_LDB(B1, 0, 1); PG8_SCHED; PG8_LDA(At, 0, 0); PG8_STAGE(PG8_SA(1, 1), a1 + hstep, voffA);
            PG8_WAIT_V(8); PG8_WAIT_L(0); PG8_BAR; PG8_MMA(0, 0, At, B0); PG8_MMA(0, 1, At, B1); PG8_BAR; PG8_SCHED;
            PG8_LDA(At, 0, 1); PG8_STAGE(PG8_SB(0, 0), b2, voffB); PG8_STAGE(PG8_SB(0, 1), b2 + hstep, voffB); PG8_STAGE(PG8_SA(0, 0), a2, voffA);
            PG8_WAIT_V(8); PG8_WAIT_L(0); PG8_BAR; PG8_MMA(1, 0, At, B0); PG8_MMA(1, 1, At, B1); PG8_BAR; PG8_SCHED;
            PG8_LDB(B0, 1, 0); PG8_LDB(B1, 1, 1); PG8_SCHED; PG8_LDA(At, 1, 0); PG8_STAGE(PG8_SA(0, 1), a2 + hstep, voffA);
            PG8_WAIT_V(8); PG8_WAIT_L(0); PG8_BAR; PG8_MMA(0, 0, At, B0); PG8_MMA(0, 1, At, B1); PG8_BAR; PG8_SCHED;
            PG8_LDA(At, 1, 1); PG8_STAGE(PG8_SB(1, 0), b3, voffB); PG8_STAGE(PG8_SB(1, 1), b3 + hstep, voffB); PG8_STAGE(PG8_SA(1, 0), a3, voffA);
            PG8_WAIT_V(8); PG8_WAIT_L(0); PG8_BAR; PG8_MMA(1, 0, At, B0); PG8_MMA(1, 1, At, B1); PG8_BAR; PG8_SCHED;
            } else {
            PG8_LDB(B0, 0, 0); PG8_SCHED; PG8_LDA(At, 0, 0); PG8_STAGE(PG8_SA(1, 1), a1 + hstep, voffA);
            PG8_WAIT_L(8); PG8_BAR; PG8_WAIT_L(0); PG8_MMA(0, 0, At, B0); PG8_BAR; PG8_SCHED;
            PG8_LDB(B1, 0, 1); PG8_STAGE(PG8_SB(0, 0), b2, voffB);
            PG8_BAR; PG8_WAIT_L(0); PG8_MMA(0, 1, At, B1); PG8_BAR;
            PG8_LDA(At, 0, 1); PG8_STAGE(PG8_SA(0, 0), a2, voffA);
            PG8_BAR; PG8_WAIT_L(0); PG8_MMA(1, 0, At, B0); PG8_BAR; PG8_SCHED;
            PG8_STAGE(PG8_SB(0, 1), b2 + hstep, voffB);
            PG8_WAIT_V(6); PG8_BAR; PG8_MMA(1, 1, At, B1); PG8_BAR;
            PG8_LDB(B0, 1, 0); PG8_SCHED; PG8_LDA(At, 1, 0); PG8_STAGE(PG8_SA(0, 1), a2 + hstep, voffA);
            PG8_WAIT_L(8); PG8_BAR; PG8_WAIT_L(0); PG8_MMA(0, 0, At, B0); PG8_BAR; PG8_SCHED;
            PG8_LDB(B1, 1, 1); PG8_STAGE(PG8_SB(1, 0), b3, voffB);
            PG8_BAR; PG8_WAIT_L(0); PG8_MMA(0, 1, At, B1); PG8_BAR;
            PG8_LDA(At, 1, 1); PG8_STAGE(PG8_SA(1, 0), a3, voffA);
            PG8_BAR; PG8_WAIT_L(0); PG8_MMA(1, 0, At, B0); PG8_BAR; PG8_SCHED;
            PG8_STAGE(PG8_SB(1, 1), b3 + hstep, voffB);
            PG8_WAIT_V(6); PG8_BAR; PG8_MMA(1, 1, At, B1); PG8_BAR;
            }
        }
        if constexpr (ALIGN_EPI) { if (wr == 0) PG8_BAR; }
        if constexpr (!Epi::AFTER_DRAIN) { E(acc, cur, wr, wc, fr, fq); S.done(cur); }
        if (!has_next) break;
#pragma unroll
        for (int a = 0; a < 2; ++a)
#pragma unroll
            for (int b = 0; b < 2; ++b)
#pragma unroll
                for (int m = 0; m < 4; ++m)
#pragma unroll
                    for (int n = 0; n < 2; ++n) acc[a][b][m][n] = (f32x4){0.f, 0.f, 0.f, 0.f};
        cur = nxt; cA = nA; cB = nB; ++ui; nt = cur.nt;
        if constexpr (ALIGN_EPI) { if (wr == 1) PG8_BAR; }
    }
    PG8_WAIT_V(0);
    if constexpr (!ALIGN_EPI) { if (wr == 0) PG8_BAR; }
    PG8_BAR;
    if constexpr (Epi::AFTER_DRAIN) { E.fused(acc, cur, wr, wc, fr, fq, lds, wid, lane); S.done(cur); }
#undef PG8_SA
#undef PG8_SB
#undef PG8_STAGE
#undef PG8_LDA
#undef PG8_LDB
#undef PG8_MMA
#undef PG8_WAIT_V
#undef PG8_WAIT_L
#undef PG8_BAR
#undef PG8_SCHED
}
}

#define LAS __attribute__((address_space(3)))
#define DI __device__ __forceinline__
using pg8::bf16_t; using pg8::bf16x8; using pg8::f32x4; using pg8::u32x4;
typedef short s16x4 __attribute__((ext_vector_type(4)));
typedef float f32x16 __attribute__((ext_vector_type(16)));
typedef float f32x2 __attribute__((ext_vector_type(2)));
typedef unsigned u32x2 __attribute__((ext_vector_type(2)));
typedef __bf16 bf16x2_t __attribute__((ext_vector_type(2)));

constexpr int NBATCH = 4, SEQ = 4096, CTXL = 256, TPB = 4352, MROWS = NBATCH * TPB, DM = 1024, DFF = 2816, DEPTH = 4, MODW = 6 * DM;
constexpr float ALPHA = 1.6817928305074290f, LOG2E = 1.4426950408889634f;
constexpr size_t MiB = 1048576;
constexpr size_t WS_MOD = 0, WS_ROPEA = 512 * 1024, WS_ROPEC = WS_ROPEA + 16384, WS_BAR = WS_ROPEC + 8192  , WS_XC = 1 * MiB, WS_H = 5 * MiB, WS_W = 39 * MiB;
constexpr size_t WS_WGU(int l) { return WS_W + (size_t)l * (33 * MiB / 2); }
constexpr size_t WS_WD(int l) { return WS_WGU(l) + 11 * MiB; }
constexpr size_t WS_WA_QKV(int j) { return WS_W + 66 * MiB + (size_t)j * 5 * MiB; }
constexpr size_t WS_WA_O(int j) { return WS_WA_QKV(j) + 3 * MiB; }
constexpr size_t WS_WB_QKV = WS_W + 76 * MiB, WS_WB_O = WS_WB_QKV + 6 * MiB;
constexpr size_t WS_WC_DQKV = WS_W + 84 * MiB, WS_WC_UQ = WS_WC_DQKV + 3 * MiB / 2, WS_WC_UKV = WS_WC_UQ + 9 * MiB / 8, WS_WC_O = WS_WC_UKV + 1 * MiB;
constexpr size_t WS_R = 129 * MiB;
constexpr size_t WS_AQ = WS_R, WS_AK = WS_R + 34 * MiB, WS_AV = WS_AK + 17 * MiB / 2;
constexpr size_t WS_BQ = WS_R, WS_BK = WS_R + 34 * MiB, WS_BV = WS_R + 68 * MiB;
constexpr size_t WS_CQ = WS_R, WS_CKV = WS_R + 51 * MiB, WS_CKR = WS_R + 119 * MiB, WS_CQL = WS_R + 122 * MiB, WS_CKVL = WS_R + 135 * MiB;
constexpr size_t WS_ACT = WS_R, WS_PART = WS_R + 96 * MiB  ;
constexpr size_t WS_END = WS_R + 144 * MiB;
static_assert(WS_WC_O + 2 * MiB <= WS_R, "weights fit");

constexpr int LDS_BYTES = 147456;

struct Params { const float* in[24]; float* out; unsigned char* ws; int ph_lo, ph_hi; };
typedef const __attribute__((address_space(4))) unsigned char* kaptr;
DI const float* KIN(kaptr ka, int i) { return *(const float* const __attribute__((address_space(4)))*)(ka + 8 * i); }
DI float* KOUT(kaptr ka) { return *(float* const __attribute__((address_space(4)))*)(ka + 192); }
DI unsigned char* KWS(kaptr ka) { return *(unsigned char* const __attribute__((address_space(4)))*)(ka + 200); }

DI unsigned pk2(float lo, float hi) { f32x2 v = {lo, hi}; return __builtin_bit_cast(unsigned, __builtin_convertvector(v, bf16x2_t)); }
DI float bflo(unsigned u) { return __uint_as_float(u << 16); }
DI float bfhi(unsigned u) { return __uint_as_float(u & 0xffff0000u); }
DI void unpack8(const u32x4 w, float (&f)[8]) { f[0] = bflo(w.x); f[1] = bfhi(w.x); f[2] = bflo(w.y); f[3] = bfhi(w.y); f[4] = bflo(w.z); f[5] = bfhi(w.z); f[6] = bflo(w.w); f[7] = bfhi(w.w); }
DI u32x4 pack8(const float (&f)[8]) { u32x4 w; w.x = pk2(f[0], f[1]); w.y = pk2(f[2], f[3]); w.z = pk2(f[4], f[5]); w.w = pk2(f[6], f[7]); return w; }
DI float wave_sum(float v) {
#pragma unroll
    for (int o = 1; o < 64; o <<= 1) v += __shfl_xor(v, o);
    return v;
}
DI float silu_f(float x) { return x * __builtin_amdgcn_rcpf(1.0f + __expf(-x)); }

struct EpiStore {
    static constexpr bool PERM = true, AFTER_DRAIN = false;
    bf16_t* p2; long long d12, d01; int ld2, dl12, dl01, c1, c2, nvalid;
    static DI EpiStore make(bf16_t* p0, bf16_t* p1, bf16_t* p2, int c1, int c2, int ld0, int ld1, int ld2, int nvalid) {
        EpiStore e; e.p2 = p2; e.d12 = (long long)(p1 - p2); e.d01 = (long long)(p0 - p1); e.ld2 = ld2; e.dl12 = ld1 - ld2; e.dl01 = ld0 - ld1; e.c1 = c1; e.c2 = c2; e.nvalid = nvalid; return e; }
    DI void operator()(const f32x4 (&acc)[2][2][4][2], const pg8::Unit& u, int wr, int wc, int fr, int fq) const {
        const int row0 = u.pm * 256 + wr * 64 + fr;
#pragma unroll
        for (int bj = 0; bj < 2; ++bj) {
            const int col = u.pn * 256 + bj * 128 + wc * 32 + 8 * fq;
            const int m0 = -(int)(col < c1), m1 = -(int)(col < c2);
            bf16_t* base = p2 + ((d12 & (long long)m1) + (d01 & (long long)m0));
            const int ld = ld2 + (dl12 & m1) + (dl01 & m0), lc = col - c2 + ((c2 - c1) & m1) + (c1 & m0);
            if (col < nvalid) {
#pragma unroll
                for (int ai = 0; ai < 2; ++ai)
#pragma unroll
                    for (int m = 0; m < 4; ++m) {
                        const f32x4 v0 = acc[ai][bj][m][0], v1 = acc[ai][bj][m][1];
                        u32x4 w; w.x = pk2(v0[0], v0[1]); w.y = pk2(v0[2], v0[3]); w.z = pk2(v1[0], v1[1]); w.w = pk2(v1[2], v1[3]);
                        *(u32x4*)(base + (size_t)(row0 + ai * 128 + m * 16) * ld + lc) = w;
                    }
            }
        }
    }
};
struct EpiResid {
    static constexpr bool PERM = true, AFTER_DRAIN = false;
    bf16_t* Y; float* part;
    DI void operator()(const f32x4 (&acc)[2][2][4][2], const pg8::Unit& u, int wr, int wc, int fr, int fq) const {
        const int rl = wr * 64 + fr;
        if (u.ks >= 0) {
            const int b = u.pm / 17;
            float* pb = part + ((size_t)u.ks * 1024 + (size_t)b * 256) * DM;
#pragma unroll
            for (int bj = 0; bj < 2; ++bj) {
                const int col = u.pn * 256 + bj * 128 + wc * 32 + 8 * fq;
#pragma unroll
                for (int ai = 0; ai < 2; ++ai)
#pragma unroll
                    for (int m = 0; m < 4; ++m) {
                        float* xp = pb + (size_t)(rl + ai * 128 + m * 16) * DM + col;
                        *(f32x4*)xp = acc[ai][bj][m][0]; *(f32x4*)(xp + 4) = acc[ai][bj][m][1];
                    }
            }
            return;
        }
        bf16_t* yb = Y + (size_t)(u.pm * 256 + rl) * DM;
#pragma unroll
        for (int bj = 0; bj < 2; ++bj) {
            const int col = u.pn * 256 + bj * 128 + wc * 32 + 8 * fq;
#pragma unroll
            for (int ai = 0; ai < 2; ++ai)
#pragma unroll
                for (int m = 0; m < 4; ++m) {
                    const f32x4 v0 = acc[ai][bj][m][0], v1 = acc[ai][bj][m][1];
                    u32x4 w; w.x = pk2(v0[0], v0[1]); w.y = pk2(v0[2], v0[3]); w.z = pk2(v1[0], v1[1]); w.w = pk2(v1[2], v1[3]);
                    *(u32x4*)(yb + (size_t)(ai * 128 + m * 16) * DM + col) = w;
                }
        }
    }
};
struct EpiSwiGLU {
    static constexpr bool PERM = true, AFTER_DRAIN = false;
    bf16_t* act;
    DI void operator()(const f32x4 (&acc)[2][2][4][2], const pg8::Unit& u, int wr, int wc, int fr, int fq) const {
        const int row0 = u.pm * 256 + wr * 64 + fr, col = u.pn * 128 + wc * 32 + 8 * fq;
#pragma unroll
        for (int ai = 0; ai < 2; ++ai)
#pragma unroll
            for (int m = 0; m < 4; ++m) {
                const f32x4 a0 = acc[ai][0][m][0], a1 = acc[ai][0][m][1], b0 = acc[ai][1][m][0], b1 = acc[ai][1][m][1];
                u32x4 w;
                w.x = pk2(silu_f(a0[0]) * b0[0], silu_f(a0[1]) * b0[1]); w.y = pk2(silu_f(a0[2]) * b0[2], silu_f(a0[3]) * b0[3]);
                w.z = pk2(silu_f(a1[0]) * b1[0], silu_f(a1[1]) * b1[1]); w.w = pk2(silu_f(a1[2]) * b1[2], silu_f(a1[3]) * b1[3]);
                *(u32x4*)(act + (size_t)(row0 + ai * 128 + m * 16) * DFF + col) = w;
            }
    }
};
template <class Epi> DI void run_gemm(LAS unsigned char* lds, int wv, const bf16_t* A, const bf16_t* Bt, int M, int N, int K, const Epi& E) {
    pg8::Gemm g{A, Bt, M, N, K}; pg8::StaticOrder S; S.init(M, N, (int)gridDim.x, bidx()); S.ntk = K / 64;
    pg8::gemm_phase<Epi, pg8::StaticOrder, true, true>(lds, g, S, E, wv);
}
struct LatCtxOrder {
    pg8::StaticOrder so; int KS, nsplit, G, c;
    DI void init(int N, int K, int KS_, int G_, int c_) { so.init(NBATCH * SEQ, N, G_, c_); so.ntk = K / 64; KS = KS_; nsplit = 4 * (N / 256) * KS_; G = G_; c = c_; }
    DI bool next(int i, pg8::Unit& u) const {
        const int L = i * G + c;
        if (L < so.nwg) { so.next(i, u); u.pm += u.pm >> 4; return true; }
        const int s = L - so.nwg; if (s >= nsplit) return false;
        const int kp = s % KS, u16 = s / KS, nN = so.nN;
        u.pm = 17 * (u16 / nN) + 16; u.pn = u16 % nN; u.nt = so.ntk / KS; u.k0 = kp * u.nt * 64; u.ks = kp; return true;
    }
    DI void a_ready(const pg8::Unit&) const {}
    DI void done(const pg8::Unit&) const {}
};
template <class Epi> DI void run_gemm_lat(LAS unsigned char* lds, int wv, const bf16_t* A, const bf16_t* Bt, int N, int K, int KS, const Epi& E) {
    pg8::Gemm g{A, Bt, MROWS, N, K}; LatCtxOrder S; S.init(N, K, KS, (int)gridDim.x, bidx());
    pg8::gemm_phase<Epi, LatCtxOrder, true, true>(lds, g, S, E, wv);
}

struct AttnArgs { const bf16_t* Q; const bf16_t* K; const bf16_t* V; const bf16_t* K2; bf16_t* O; const float* gain; const float* rpb; const f32x2* rope; };
DI int crow(int i, int h) { return (i & 3) + 8 * (i >> 2) + 4 * h; }

template <int MODE> DI void attn_phase(LAS unsigned char* lds, const AttnArgs a, int wv, bool with_ctx) {
    constexpr int DK = MODE == 0 ? 128 : (MODE == 1 ? 64 : 192), DV = MODE == 1 ? 64 : 128;
    constexpr int KT = MODE == 2 ? 192 : 128, VT = 128;
    constexpr int KSTR = KT * 2 + 16, VSTR = VT * 2 + 64, VOFF = 64 * KSTR, BOFF = VOFF + 64 * VSTR;
    constexpr int KCH = KT / 8, VCH = VT / 8, NKC = KT / 64, NVC = VT / 64, NS = DK / 16, NVB = DV / 32;
    constexpr int QLD = MODE == 2 ? 1536 : 1024;
    constexpr float QS = (MODE == 0 ? 0.08838834764831845f : (MODE == 1 ? 0.125f : 0.07216878364870322f)) * LOG2E;
    const int tid = tidx(wv), w = __builtin_amdgcn_readfirstlane(tid >> 6);
    const int nunits = MODE == 1 ? (with_ctx ? 1088 : 1024) : (with_ctx ? 544 : 512);
    const int kc0 = MODE == 1 ? 64 * ((w >> 1) & 1) : 0;
    for (int it_ = bidx(); it_ < nunits; it_ += gridDim.x) {
        int u = it_;
        if (MODE != 1 && gridDim.x == 256 && it_ < 512) u = (((it_ >> 8) * 8 + (it_ & 7)) * 32) + ((it_ >> 3) & 31);
        int tu_ = tid; asm volatile("" : "+v"(tu_));
        const int lane = tu_ & 63, r = lane & 31, h = lane >> 5;
        int b, head, hq = 0, qpos, nloc, base0, ntiles, rr = 0, rs = 0, rs0 = 0;
        if (MODE == 1) {
            if (u < 1024) { b = u >> 8; const int rp = (u >> 3) & 31; hq = u & 7; rr = 2 * rp + (w >> 2); qpos = rr * 64 + 32 * (w & 1) + r;
                const int rsA = min(max(2 * rp - 4, 0), 56), rsB = min(max(2 * rp - 3, 0), 56); rs = (w >> 2) ? rsB : rsA; rs0 = rsA; nloc = rsB - rsA + 8; base0 = rsA * 64; ntiles = nloc + 4; }
            else { const int v = u - 1024; b = v >> 4; hq = v & 7; qpos = 4096 + (2 * ((v >> 3) & 1) + (w >> 2)) * 64 + 32 * (w & 1) + r; nloc = 0; base0 = 0; ntiles = 4; }
            head = 2 * hq + ((w >> 1) & 1);
        } else {
            if (u < 512) { b = u >> 7; head = (u >> 4) & 7; qpos = (u & 15) * 256 + 32 * w + r; nloc = 68; base0 = 0; ntiles = 68; }
            else { const int v = u - 512; b = v >> 3; head = v & 7; qpos = 4096 + 32 * w + r; nloc = 0; base0 = 0; ntiles = 4; }
        }
        const int kvh = head >> 2;
        const size_t rowb = (size_t)b * TPB;
        const bool lat = qpos < 4096;
        bf16x8 qf[NS];
        {
            const bf16_t* qp = a.Q + (rowb + qpos) * QLD + head * DK + 8 * h;
            u32x4 qraw[NS];
#pragma unroll
            for (int s = 0; s < NS; ++s) qraw[s] = *(const u32x4*)(qp + 16 * s);
            if (MODE == 0) {
                float ss = 0.f;
#pragma unroll
                for (int s = 0; s < NS; ++s) { float f[8]; unpack8(qraw[s], f);
#pragma unroll
                    for (int e = 0; e < 8; ++e) ss += f[e] * f[e]; }
                ss += __shfl_xor(ss, 32);
                const float rstd = rsqrtf(ss * (1.0f / 128.0f) + 1e-6f) * QS;
                const int pr = qpos >> 6, pc = qpos & 63;
#pragma unroll
                for (int g = 0; g < 4; ++g) {
                    const int s0 = (g & 1) + 4 * (g >> 1), s1 = s0 + 2, pos = (g >> 1) ? pc : pr, i0 = 16 * (g & 1) + 8 * h;
                    float t1[8], t2[8], o1[8], o2[8]; unpack8(qraw[s0], t1); unpack8(qraw[s1], t2);
                    const float* g1 = a.gain + 16 * s0 + 8 * h; const float* g2 = a.gain + 16 * s1 + 8 * h;
#pragma unroll
                    for (int e = 0; e < 8; ++e) {
                        f32x2 cs = a.rope[pos * 32 + i0 + e]; if (!lat) { cs.x = 1.f; cs.y = 0.f; }
                        const float x1 = t1[e] * rstd * g1[e], x2 = t2[e] * rstd * g2[e];
                        o1[e] = x1 * cs.x - x2 * cs.y; o2[e] = x2 * cs.x + x1 * cs.y;
                    }
                    qraw[s0] = pack8(o1); qraw[s1] = pack8(o2);
                    asm volatile("" ::: "memory");
                }
            } else if (MODE == 1) {
#pragma unroll
                for (int s = 0; s < NS; ++s) { float f[8]; unpack8(qraw[s], f);
#pragma unroll
                    for (int e = 0; e < 8; ++e) f[e] *= QS;
                    qraw[s] = pack8(f); }
            } else {
#pragma unroll
                for (int s = 0; s < 8; ++s) { float f[8]; unpack8(qraw[s], f);
#pragma unroll
                    for (int e = 0; e < 8; ++e) f[e] *= QS;
                    qraw[s] = pack8(f); }
#ifndef EXP_NOROPE2
                const int pr = qpos >> 6, pc = qpos & 63;
#pragma unroll
                for (int g = 0; g < 2; ++g) {
                    const int s0 = 8 + 2 * g, s1 = s0 + 1, pos = g ? pc : pr;
                    float t1[8], t2[8], o1[8], o2[8]; unpack8(qraw[s0], t1); unpack8(qraw[s1], t2);
#pragma unroll
                    for (int e = 0; e < 8; ++e) {
                        f32x2 cs = a.rope[pos * 16 + 8 * h + e]; if (!lat) { cs.x = 1.f; cs.y = 0.f; }
                        const float x1 = t1[e] * QS, x2 = t2[e] * QS;
                        o1[e] = x1 * cs.x - x2 * cs.y; o2[e] = x2 * cs.x + x1 * cs.y;
                    }
                    qraw[s0] = pack8(o1); qraw[s1] = pack8(o2);
                    asm volatile("" ::: "memory");
                }
#endif
            }
#pragma unroll
            for (int s = 0; s < NS; ++s) qf[s] = __builtin_bit_cast(bf16x8, qraw[s]);
        }
        __syncthreads();
        if (MODE == 1 && nloc > 0) {
            LAS float* bl = (LAS float*)(lds + BOFF);
            for (int t = tid; t < 2 * 465; t += 512) bl[t] = a.rpb[(size_t)(2 * hq) * 465 + t] * LOG2E;
        }
        f32x16 oacc[NVB];
#pragma unroll
        for (int vb = 0; vb < NVB; ++vb)
#pragma unroll
            for (int i = 0; i < 16; ++i) oacc[vb][i] = 0.f;
        float mrun = 0.f, lrun = 0.f;
        u32x4 kreg[NKC], vreg[NVC];
#define ATT_LOAD_TILE(kp) do { \
        _Pragma("unroll") for (int i_ = 0; i_ < NKC; ++i_) { const int ci = tl_ + 512 * i_, kr = ci / KCH, cc = ci - kr * KCH; const size_t row = rowb + (kp) + kr; const bf16_t* src; \
            if (MODE == 0) src = a.K + row * 256 + kvh * 128 + cc * 8; else if (MODE == 1) src = a.K + row * 1024 + hq * 128 + cc * 8; \
            else src = (cc < 16) ? a.K + row * 2048 + head * 256 + cc * 8 : a.K2 + row * 64 + (cc - 16) * 8; \
            kreg[i_] = *(const u32x4*)src; } \
        _Pragma("unroll") for (int i_ = 0; i_ < NVC; ++i_) { const int ci = tl_ + 512 * i_, kr = ci / VCH, cc = ci - kr * VCH; const size_t row = rowb + (kp) + kr; const bf16_t* src; \
            if (MODE == 0) src = a.V + row * 256 + kvh * 128 + cc * 8; else if (MODE == 1) src = a.V + row * 1024 + hq * 128 + cc * 8; \
            else src = a.V + row * 2048 + head * 256 + 128 + cc * 8; \
            vreg[i_] = *(const u32x4*)src; } } while (0)
        { int tl_ = tid; asm volatile("" : "+v"(tl_)); ATT_LOAD_TILE(nloc > 0 ? base0 : 4096); }
        for (int j = 0; j < ntiles; ++j) {
            int tl_ = tid; asm volatile("" : "+v"(tl_));
            const int ln_ = tl_ & 63, r = ln_ & 31, h = ln_ >> 5;
            __syncthreads();
#pragma unroll
            for (int i_ = 0; i_ < NKC; ++i_) { const int ci = tl_ + 512 * i_, kr = ci / KCH, cc = ci - kr * KCH; *(LAS u32x4*)(lds + kr * KSTR + cc * 16) = kreg[i_]; }
#pragma unroll
            for (int i_ = 0; i_ < NVC; ++i_) { const int ci = tl_ + 512 * i_, kr = ci / VCH, cc = ci - kr * VCH; *(LAS u32x4*)(lds + VOFF + kr * VSTR + cc * 16) = vreg[i_]; }
            __syncthreads();
            if (j + 1 < ntiles) { const int jn = j + 1; const int kpn = jn < nloc ? base0 + 64 * jn : 4096 + 64 * (jn - nloc); ATT_LOAD_TILE(kpn); }
            if (!(MODE == 1 && j < nloc && (rs0 + j < rs || rs0 + j > rs + 7))) {
            f32x16 sacc[2];
#pragma unroll
            for (int kb = 0; kb < 2; ++kb)
#pragma unroll
                for (int i = 0; i < 16; ++i) sacc[kb][i] = -mrun;
#pragma unroll
            for (int s = 0; s < NS; ++s) {
#pragma unroll
                for (int kb = 0; kb < 2; ++kb) {
                    const bf16x8 kf = *(const LAS bf16x8*)(lds + (32 * kb + r) * KSTR + (kc0 + 16 * s + 8 * h) * 2);
                    sacc[kb] = __builtin_amdgcn_mfma_f32_32x32x16_bf16(kf, qf[s], sacc[kb], 0, 0, 0);
                }
                if ((s & 1) == 1) asm volatile("" ::: "memory");
            }
            if (MODE == 1 && j < nloc) {
                const int c = qpos & 63, cs = min(max(c - 8, 0), 48), dr = rs0 + j - rr + 7;
                const LAS float* bl = (const LAS float*)(lds + BOFF) + (((w >> 1) & 1) * 15 + dr) * 31 + 15 - c;
#pragma unroll
                for (int kb = 0; kb < 2; ++kb) {
#pragma unroll
                    for (int i = 0; i < 16; ++i) {
                        const int jc = 32 * kb + crow(i, h); const bool ok = (unsigned)(jc - cs) < 16u;
                        const float bias = bl[ok ? jc : c];
                        sacc[kb][i] = ok ? sacc[kb][i] + bias : -1e30f;
                        if ((i & 7) == 7) asm volatile("" ::: "memory");
                    }
                }
            }
            float mx = sacc[0][0];
#pragma unroll
            for (int kb = 0; kb < 2; ++kb)
#pragma unroll
                for (int i = 0; i < 16; ++i) mx = fmaxf(mx, sacc[kb][i]);
            mx = fmaxf(mx, __shfl_xor(mx, 32));
            if (!__all(mx <= 8.0f)) {
                const float d = fmaxf(mx, 0.f), alpha = __builtin_amdgcn_exp2f(-d);
                mrun += d; lrun *= alpha;
#pragma unroll
                for (int vb = 0; vb < NVB; ++vb)
#pragma unroll
                    for (int i = 0; i < 16; ++i) oacc[vb][i] *= alpha;
#pragma unroll
                for (int kb = 0; kb < 2; ++kb)
#pragma unroll
                    for (int i = 0; i < 16; ++i) sacc[kb][i] -= d;
            }
            f32x2 sum2 = {0.f, 0.f};
#pragma unroll
            for (int kb = 0; kb < 2; ++kb)
#pragma unroll
                for (int i = 0; i < 16; i += 2) {
                    f32x2 pp; pp.x = __builtin_amdgcn_exp2f(sacc[kb][i]); pp.y = __builtin_amdgcn_exp2f(sacc[kb][i + 1]);
                    sacc[kb][i] = pp.x; sacc[kb][i + 1] = pp.y; sum2 += pp;
                }
            float sum = sum2.x + sum2.y;
            asm volatile("" : "+v"(sum));
            lrun += sum;
            bf16x8 pf[4];
#pragma unroll
            for (int t = 0; t < 4; ++t) {
                const int kb = t >> 1, o = 8 * (t & 1);
                u32x4 pw; pw.x = pk2(sacc[kb][o], sacc[kb][o + 1]); pw.y = pk2(sacc[kb][o + 2], sacc[kb][o + 3]); pw.z = pk2(sacc[kb][o + 4], sacc[kb][o + 5]); pw.w = pk2(sacc[kb][o + 6], sacc[kb][o + 7]);
                pf[t] = __builtin_bit_cast(bf16x8, pw);
            }
            {
                const int i16 = ln_ & 15, q4 = i16 >> 2, p4 = i16 & 3, g1 = (ln_ >> 4) & 1;
                LAS unsigned char* vbase = lds + VOFF + (4 * h + q4) * VSTR + (kc0 + 16 * g1) * 2 + 8 * p4;
#pragma unroll
                for (int t = 0; t < 4; ++t) {
#pragma unroll
                    for (int vb = 0; vb < NVB; ++vb) {
                        const s16x4 lo = __builtin_amdgcn_ds_read_tr16_b64_v4i16((LAS s16x4*)(vbase + (16 * t) * VSTR + 64 * vb));
                        const s16x4 hi = __builtin_amdgcn_ds_read_tr16_b64_v4i16((LAS s16x4*)(vbase + (16 * t + 8) * VSTR + 64 * vb));
                        const bf16x8 va = __builtin_shufflevector(lo, hi, 0, 1, 2, 3, 4, 5, 6, 7);
                        oacc[vb] = __builtin_amdgcn_mfma_f32_32x32x16_bf16(va, pf[t], oacc[vb], 0, 0, 0);
                    }
                    asm volatile("" ::: "memory");
                }
            }
            }
        }
#undef ATT_LOAD_TILE
        {
            lrun += __shfl_xor(lrun, 32);
            const float inv = 1.0f / lrun;
            bf16_t* op = a.O + (rowb + qpos) * 1024 + head * DV + 4 * h;
#pragma unroll
            for (int vb = 0; vb < NVB; ++vb)
#pragma unroll
                for (int g = 0; g < 4; ++g) {
                    u32x2 wv; wv.x = pk2(oacc[vb][4 * g] * inv, oacc[vb][4 * g + 1] * inv); wv.y = pk2(oacc[vb][4 * g + 2] * inv, oacc[vb][4 * g + 3] * inv);
                    *(u32x2*)(op + 32 * vb + 8 * g) = wv;
                }
        }
    }
    __syncthreads();
}

DI void attn_phase16(LAS unsigned char* lds, const AttnArgs a, int wv, bool with_ctx) {
    constexpr int KSTR = 288, VSTR = 288, VOFF = 64 * KSTR;
    constexpr int KCH = 16, VCH = 16, NKC = 2, NVC = 2;
    constexpr float QS = 0.08838834764831845f * LOG2E;
    const int tid = tidx(wv), w = __builtin_amdgcn_readfirstlane(tid >> 6);
    const int nunits = with_ctx ? 544 : 512;
    for (int it_ = bidx(); it_ < nunits; it_ += gridDim.x) {
        int u = it_;
        if (gridDim.x == 256 && it_ < 512) u = (((it_ >> 8) * 8 + (it_ & 7)) * 32) + ((it_ >> 3) & 31);
        int tu_ = tid; asm volatile("" : "+v"(tu_));
        const int lane = tu_ & 63, c = lane & 15, g = lane >> 4;
        int b, head, q0, ntiles, kbase0;
        if (u < 512) { b = u >> 7; head = (u >> 4) & 7; q0 = (u & 15) * 256 + 32 * w; ntiles = 68; kbase0 = 0; }
        else { const int v = u - 512; b = v >> 3; head = v & 7; q0 = 4096 + 32 * w; ntiles = 4; kbase0 = 4096; }
        const int kvh = head >> 2;
        const size_t rowb = (size_t)b * TPB;
        const bool lat = q0 < 4096;
        bf16x8 qf[2][4];
#pragma unroll
        for (int qb = 0; qb < 2; ++qb) {
            const int qpos = q0 + 16 * qb + c;
            const bf16_t* qp = a.Q + (rowb + qpos) * 1024 + head * 128 + 8 * g;
            u32x4 qraw[4];
#pragma unroll
            for (int s = 0; s < 4; ++s) qraw[s] = *(const u32x4*)(qp + 32 * s);
            float ss = 0.f;
#pragma unroll
            for (int s = 0; s < 4; ++s) { float f[8]; unpack8(qraw[s], f);
#pragma unroll
                for (int e = 0; e < 8; ++e) ss += f[e] * f[e]; }
            ss += __shfl_xor(ss, 16); ss += __shfl_xor(ss, 32);
            const float rstd = rsqrtf(ss * (1.0f / 128.0f) + 1e-6f) * QS;
            const int pr = qpos >> 6, pc = qpos & 63;
#pragma unroll
            for (int gg = 0; gg < 2; ++gg) {
                const int s0 = 2 * gg, s1 = s0 + 1, pos = gg ? pc : pr;
                float t1[8], t2[8], o1[8], o2[8]; unpack8(qraw[s0], t1); unpack8(qraw[s1], t2);
                const float* g1 = a.gain + 32 * s0 + 8 * g; const float* g2 = a.gain + 32 * s1 + 8 * g;
#pragma unroll
                for (int e = 0; e < 8; ++e) {
                    f32x2 cs = a.rope[pos * 32 + 8 * g + e]; if (!lat) { cs.x = 1.f; cs.y = 0.f; }
                    const float x1 = t1[e] * rstd * g1[e], x2 = t2[e] * rstd * g2[e];
                    o1[e] = x1 * cs.x - x2 * cs.y; o2[e] = x2 * cs.x + x1 * cs.y;
                }
                qraw[s0] = pack8(o1); qraw[s1] = pack8(o2);
                asm volatile("" ::: "memory");
            }
#pragma unroll
            for (int s = 0; s < 4; ++s) qf[qb][s] = __builtin_bit_cast(bf16x8, qraw[s]);
        }
        __syncthreads();
        f32x4 oacc[2][8];
#pragma unroll
        for (int qb = 0; qb < 2; ++qb)
#pragma unroll
            for (int vb = 0; vb < 8; ++vb) oacc[qb][vb] = (f32x4){0.f, 0.f, 0.f, 0.f};
        float mrun[2] = {0.f, 0.f}, lrun[2] = {0.f, 0.f};
        u32x4 kreg[NKC], vreg[NVC];
#define A16_LOAD(kp) do { \
        _Pragma("unroll") for (int i_ = 0; i_ < NKC; ++i_) { const int ci = tl_ + 512 * i_, kr = ci / KCH, cc = ci - kr * KCH; kreg[i_] = *(const u32x4*)(a.K + (rowb + (kp) + kr) * 256 + kvh * 128 + cc * 8); } \
        _Pragma("unroll") for (int i_ = 0; i_ < NVC; ++i_) { const int ci = tl_ + 512 * i_, kr = ci / VCH, cc = ci - kr * VCH; vreg[i_] = *(const u32x4*)(a.V + (rowb + (kp) + kr) * 256 + kvh * 128 + cc * 8); } } while (0)
        { int tl_ = tid; asm volatile("" : "+v"(tl_)); A16_LOAD(kbase0); }
        for (int j = 0; j < ntiles; ++j) {
            int tl_ = tid; asm volatile("" : "+v"(tl_));
            const int ln_ = tl_ & 63, c = ln_ & 15, g = ln_ >> 4;
            __syncthreads();
#pragma unroll
            for (int i_ = 0; i_ < NKC; ++i_) { const int ci = tl_ + 512 * i_, kr = ci / KCH, cc = ci - kr * KCH; *(LAS u32x4*)(lds + kr * KSTR + cc * 16) = kreg[i_]; }
#pragma unroll
            for (int i_ = 0; i_ < NVC; ++i_) { const int ci = tl_ + 512 * i_, kr = ci / VCH, cc = ci - kr * VCH; *(LAS u32x4*)(lds + VOFF + kr * VSTR + cc * 16) = vreg[i_]; }
            __syncthreads();
            if (j + 1 < ntiles) A16_LOAD(kbase0 + 64 * (j + 1));
            f32x4 sacc[2][4];
#pragma unroll
            for (int qb = 0; qb < 2; ++qb)
#pragma unroll
                for (int kb = 0; kb < 4; ++kb) { const float nm = -mrun[qb]; sacc[qb][kb] = (f32x4){nm, nm, nm, nm}; }
            const LAS unsigned char* kbase = lds + c * KSTR + 16 * g;
#pragma unroll
            for (int s = 0; s < 4; ++s) {
#pragma unroll
                for (int kb = 0; kb < 4; ++kb) {
                    const bf16x8 kf = *(const LAS bf16x8*)(kbase + 16 * kb * KSTR + 64 * s);
                    sacc[0][kb] = __builtin_amdgcn_mfma_f32_16x16x32_bf16(kf, qf[0][s], sacc[0][kb], 0, 0, 0);
                    sacc[1][kb] = __builtin_amdgcn_mfma_f32_16x16x32_bf16(kf, qf[1][s], sacc[1][kb], 0, 0, 0);
                }
                if (s & 1) asm volatile("" ::: "memory");
            }
            float mx[2];
#pragma unroll
            for (int qb = 0; qb < 2; ++qb) {
                float m_ = sacc[qb][0][0];
#pragma unroll
                for (int kb = 0; kb < 4; ++kb)
#pragma unroll
                    for (int jj = 0; jj < 4; ++jj) m_ = fmaxf(m_, sacc[qb][kb][jj]);
                m_ = fmaxf(m_, __shfl_xor(m_, 16)); m_ = fmaxf(m_, __shfl_xor(m_, 32));
                mx[qb] = m_;
            }
            if (!__all(fmaxf(mx[0], mx[1]) <= 8.0f)) {
#pragma unroll
                for (int qb = 0; qb < 2; ++qb) {
                    const float d = fmaxf(mx[qb], 0.f), alpha = __builtin_amdgcn_exp2f(-d);
                    mrun[qb] += d; lrun[qb] *= alpha;
#pragma unroll
                    for (int vb = 0; vb < 8; ++vb) oacc[qb][vb] *= alpha;
#pragma unroll
                    for (int kb = 0; kb < 4; ++kb) sacc[qb][kb] -= d;
                }
            }
            bf16x8 pf[2][2];
#pragma unroll
            for (int qb = 0; qb < 2; ++qb) {
                float sum = 0.f;
#pragma unroll
                for (int kb = 0; kb < 4; ++kb)
#pragma unroll
                    for (int jj = 0; jj < 4; ++jj) { const float pp = __builtin_amdgcn_exp2f(sacc[qb][kb][jj]); sacc[qb][kb][jj] = pp; sum += pp; }
                asm volatile("" : "+v"(sum));
                lrun[qb] += sum;
#pragma unroll
                for (int t = 0; t < 2; ++t) {
                    u32x4 pw; pw.x = pk2(sacc[qb][2 * t][0], sacc[qb][2 * t][1]); pw.y = pk2(sacc[qb][2 * t][2], sacc[qb][2 * t][3]);
                    pw.z = pk2(sacc[qb][2 * t + 1][0], sacc[qb][2 * t + 1][1]); pw.w = pk2(sacc[qb][2 * t + 1][2], sacc[qb][2 * t + 1][3]);
                    pf[qb][t] = __builtin_bit_cast(bf16x8, pw);
                }
            }
            {
                LAS unsigned char* vbase = lds + VOFF + (4 * g + (c >> 2)) * VSTR + 8 * (c & 3);
#pragma unroll
                for (int t = 0; t < 2; ++t) {
#pragma unroll
                    for (int vb = 0; vb < 8; ++vb) {
                        const s16x4 lo = __builtin_amdgcn_ds_read_tr16_b64_v4i16((LAS s16x4*)(vbase + (32 * t) * VSTR + 32 * vb));
                        const s16x4 hi = __builtin_amdgcn_ds_read_tr16_b64_v4i16((LAS s16x4*)(vbase + (32 * t + 16) * VSTR + 32 * vb));
                        const bf16x8 va = __builtin_shufflevector(lo, hi, 0, 1, 2, 3, 4, 5, 6, 7);
                        oacc[0][vb] = __builtin_amdgcn_mfma_f32_16x16x32_bf16(va, pf[0][t], oacc[0][vb], 0, 0, 0);
                        oacc[1][vb] = __builtin_amdgcn_mfma_f32_16x16x32_bf16(va, pf[1][t], oacc[1][vb], 0, 0, 0);
                        if (vb == 7) asm volatile("" ::: "memory");
                    }
                }
            }
        }
#undef A16_LOAD
#pragma unroll
        for (int qb = 0; qb < 2; ++qb) {
            float l_ = lrun[qb]; l_ += __shfl_xor(l_, 16); l_ += __shfl_xor(l_, 32);
            const float inv = 1.0f / l_;
            bf16_t* op = a.O + (rowb + q0 + 16 * qb + c) * 1024 + head * 128 + 4 * g;
#pragma unroll
            for (int vb = 0; vb < 8; ++vb) {
                u32x2 w2; w2.x = pk2(oacc[qb][vb][0] * inv, oacc[qb][vb][1] * inv); w2.y = pk2(oacc[qb][vb][2] * inv, oacc[qb][vb][3] * inv);
                *(u32x2*)(op + 16 * vb) = w2;
            }
        }
    }
    __syncthreads();
}

DI float* xrow_ptr(float* xlat, float* xctx, int m) { const int b = m / TPB, pos = m - b * TPB; return pos < 4096 ? xlat + ((size_t)b * 4096 + pos) * DM : xctx + ((size_t)b * 256 + (pos - 4096)) * DM; }
DI int modrow(int m) { const int b = m / TPB, pos = m - b * TPB; return pos < 4096 ? b : 4; }

struct RowPar { f32x4 G[4], B[4], GT[4], SH[4], SC[4]; };
template <bool LN> DI void rows_load(kaptr p, int b, int pos, int lane, f32x4 (&v)[4], int ctx_ks, const float* gate, const bf16_t* Y, bool x_in, const RowPar& P) {
    const float* src;
    if (!LN || x_in) src = pos < 4096 ? KIN(p, 0) + ((size_t)b * 4096 + pos) * DM : KIN(p, 2) + ((size_t)b * 256 + (pos - 4096)) * DM;
    else src = pos < 4096 ? KOUT(p) + ((size_t)b * 4096 + pos) * DM : (const float*)(KWS(p) + WS_XC) + ((size_t)b * 256 + (pos - 4096)) * DM;
    if (!LN) {
#pragma unroll
        for (int j = 0; j < 4; ++j) v[j] = *(const f32x4*)(src + 4 * lane + 256 * j);
    } else if (pos >= 4096) {
        const float* pp = (const float*)(KWS(p) + WS_PART) + ((size_t)b * 256 + (pos - 4096)) * DM + 4 * lane;
        const float* gp = gate + (size_t)4 * MODW + 4 * lane;
#pragma unroll
        for (int j = 0; j < 4; ++j) {
            f32x4 a = *(const f32x4*)(pp + 256 * j);
            for (int ks = 1; ks < ctx_ks; ++ks) a += *(const f32x4*)(pp + (size_t)ks * 1024 * DM + 256 * j);
            v[j] = *(const f32x4*)(src + 4 * lane + 256 * j) * ALPHA + *(const f32x4*)(gp + 256 * j) * a;
        }
    } else {
        const bf16_t* yp = Y + ((size_t)b * TPB + pos) * DM + 4 * lane;
#pragma unroll
        for (int j = 0; j < 4; ++j) {
            const u32x2 yw = *(const u32x2*)(yp + 256 * j);
            const f32x4 y = {bflo(yw.x), bfhi(yw.x), bflo(yw.y), bfhi(yw.y)};
            v[j] = *(const f32x4*)(src + 4 * lane + 256 * j) * ALPHA + P.GT[j] * y;
        }
    }
}
template <bool LN> DI void rows_finish(kaptr p, int b, int pos, int lane, f32x4 (&v)[4], const float* modp, bool write_h, const RowPar& P) {
    float* xr = pos < 4096 ? KOUT(p) + ((size_t)b * 4096 + pos) * DM : (float*)(KWS(p) + WS_XC) + ((size_t)b * 256 + (pos - 4096)) * DM;
    if (LN) {
        float s = 0.f;
#pragma unroll
        for (int j = 0; j < 4; ++j) s += (v[j].x + v[j].y) + (v[j].z + v[j].w);
        const float mean = wave_sum(s) * (1.0f / DM);
        float s2 = 0.f;
#pragma unroll
        for (int j = 0; j < 4; ++j) { v[j] = v[j] - mean; s2 += (v[j].x * v[j].x + v[j].y * v[j].y) + (v[j].z * v[j].z + v[j].w * v[j].w); }
        const float rstd = rsqrtf(wave_sum(s2) * (1.0f / DM) + 1e-5f);
#pragma unroll
        for (int j = 0; j < 4; ++j) v[j] = v[j] * rstd * P.G[j] + P.B[j];
#pragma unroll
        for (int j = 0; j < 4; ++j) *(f32x4*)(xr + 4 * lane + 256 * j) = v[j];
    }
    if (write_h) {
        bf16_t* H = (bf16_t*)(KWS(p) + WS_H) + ((size_t)b * TPB + pos) * DM;
        if (pos < 4096) {
#pragma unroll
            for (int j = 0; j < 4; ++j) { const f32x4 hh = v[j] * (P.SC[j] + 1.0f) + P.SH[j]; u32x2 w2; w2.x = pk2(hh.x, hh.y); w2.y = pk2(hh.z, hh.w); *(u32x2*)(H + 4 * lane + 256 * j) = w2; }
        } else {
            const float* mp = modp + (size_t)4 * MODW;
#pragma unroll
            for (int j = 0; j < 4; ++j) { const f32x4 sh = *(const f32x4*)(mp + 4 * lane + 256 * j), sc = *(const f32x4*)(mp + DM + 4 * lane + 256 * j);
                const f32x4 hh = v[j] * (sc + 1.0f) + sh; u32x2 w2; w2.x = pk2(hh.x, hh.y); w2.y = pk2(hh.z, hh.w); *(u32x2*)(H + 4 * lane + 256 * j) = w2; }
        }
    }
}
template <bool LN> DI void rows_phase(kaptr p, int wv, const float* lng, const float* lnb, const float* modp, bool write_h, int ctx_ks = 0, const float* gate = nullptr, const bf16_t* Y = nullptr, bool x_in = false) {
    const int lane = tidx(wv) & 63, gw = bidx() * 8 + (tidx(wv) >> 6), NW4 = (gridDim.x * 8) >> 2;
    const int b = gw & 3, w4 = gw >> 2;
    RowPar P;
#pragma unroll
    for (int j = 0; j < 4; ++j) {
        const f32x4 z4 = {0.f, 0.f, 0.f, 0.f};
        P.G[j] = LN ? *(const f32x4*)(lng + 4 * lane + 256 * j) : z4; P.B[j] = LN ? *(const f32x4*)(lnb + 4 * lane + 256 * j) : z4;
        P.GT[j] = LN ? *(const f32x4*)(gate + (size_t)b * MODW + 4 * lane + 256 * j) : z4;
        P.SH[j] = write_h ? *(const f32x4*)(modp + (size_t)b * MODW + 4 * lane + 256 * j) : z4; P.SC[j] = write_h ? *(const f32x4*)(modp + (size_t)b * MODW + DM + 4 * lane + 256 * j) : z4;
    }
    const int limit = ctx_ks < 0 ? SEQ : TPB;
    for (int pos = w4; pos < limit; pos += 2 * NW4) {
        const int pos2 = pos + NW4; const bool two = pos2 < limit;
        f32x4 va[4], vb[4];
        rows_load<LN>(p, b, pos, lane, va, ctx_ks, gate, Y, x_in, P);
        if (two) rows_load<LN>(p, b, pos2, lane, vb, ctx_ks, gate, Y, x_in, P);
        rows_finish<LN>(p, b, pos, lane, va, modp, write_h, P);
        if (two) rows_finish<LN>(p, b, pos2, lane, vb, modp, write_h, P);
    }
}

DI void kpost_a(kaptr p, int wv, const float* kgain) {
    bf16_t* K = (bf16_t*)(KWS(p) + WS_AK); const f32x2* rope = (const f32x2*)(KWS(p) + WS_ROPEA);
    const int lane = tidx(wv) & 63, j16 = lane & 15, sub = lane >> 4, gw = bidx() * 8 + (tidx(wv) >> 6), NGW = gridDim.x * 8;
    for (int it = gw; it < MROWS * 2 / 4; it += NGW) {
        const int item = it * 4 + sub, m = item >> 1, kvh = item & 1;
        const int b = m / TPB, pos = m - b * TPB; const bool lat = pos < 4096;
        unsigned* kp = (unsigned*)(K + (size_t)m * 256 + kvh * 128) + j16;
        float v[4][2]; float ss = 0.f;
#pragma unroll
        for (int k = 0; k < 4; ++k) { const unsigned wv = kp[16 * k]; v[k][0] = bflo(wv); v[k][1] = bfhi(wv); ss += v[k][0] * v[k][0] + v[k][1] * v[k][1]; }
        ss += __shfl_xor(ss, 1); ss += __shfl_xor(ss, 2); ss += __shfl_xor(ss, 4); ss += __shfl_xor(ss, 8);
        const float rstd = rsqrtf(ss * (1.0f / 128.0f) + 1e-6f);
#pragma unroll
        for (int k = 0; k < 4; ++k) { v[k][0] *= rstd * kgain[32 * k + 2 * j16]; v[k][1] *= rstd * kgain[32 * k + 2 * j16 + 1]; }
        if (lat) {
            const int pr = pos >> 6, pc = pos & 63;
#pragma unroll
            for (int g = 0; g < 2; ++g)
#pragma unroll
                for (int e = 0; e < 2; ++e) {
                    const f32x2 cs = rope[(g ? pc : pr) * 32 + 2 * j16 + e];
                    const float t1 = v[2 * g][e], t2 = v[2 * g + 1][e];
                    v[2 * g][e] = t1 * cs.x - t2 * cs.y; v[2 * g + 1][e] = t2 * cs.x + t1 * cs.y;
                }
        }
#pragma unroll
        for (int k = 0; k < 4; ++k) kp[16 * k] = pk2(v[k][0], v[k][1]);
    }
}
DI void post_c(kaptr p, int wv, const float* qg, const float* kvg) {
    bf16_t* QL = (bf16_t*)(KWS(p) + WS_CQL); bf16_t* KVL = (bf16_t*)(KWS(p) + WS_CKVL); bf16_t* KR = (bf16_t*)(KWS(p) + WS_CKR); const f32x2* rope = (const f32x2*)(KWS(p) + WS_ROPEC);
    const int lane = tidx(wv) & 63, gw = bidx() * 8 + (tidx(wv) >> 6), NGW = gridDim.x * 8;
    for (int m = gw; m < MROWS; m += NGW) {
        const int b = m / TPB, pos = m - b * TPB;
        {   unsigned* qp = (unsigned*)(QL + (size_t)m * 384) + lane; float v[3][2]; float ss = 0.f;
#pragma unroll
            for (int k = 0; k < 3; ++k) { const unsigned wv = qp[64 * k]; v[k][0] = bflo(wv); v[k][1] = bfhi(wv); ss += v[k][0] * v[k][0] + v[k][1] * v[k][1]; }
            const float rstd = rsqrtf(wave_sum(ss) * (1.0f / 384.0f) + 1e-6f);
#pragma unroll
            for (int k = 0; k < 3; ++k) qp[64 * k] = pk2(v[k][0] * rstd * qg[128 * k + 2 * lane], v[k][1] * rstd * qg[128 * k + 2 * lane + 1]); }
        {   unsigned* kp = (unsigned*)(KVL + (size_t)m * 256) + lane; float v[2][2]; float ss = 0.f;
#pragma unroll
            for (int k = 0; k < 2; ++k) { const unsigned wv = kp[64 * k]; v[k][0] = bflo(wv); v[k][1] = bfhi(wv); ss += v[k][0] * v[k][0] + v[k][1] * v[k][1]; }
            const float rstd = rsqrtf(wave_sum(ss) * (1.0f / 256.0f) + 1e-6f);
#pragma unroll
            for (int k = 0; k < 2; ++k) kp[64 * k] = pk2(v[k][0] * rstd * kvg[128 * k + 2 * lane], v[k][1] * rstd * kvg[128 * k + 2 * lane + 1]); }
        if (pos < 4096 && lane < 32) {
            const int g = lane >> 4, i = lane & 15; bf16_t* kr = KR + (size_t)m * 64 + 32 * g + i;
            const f32x2 cs = rope[(g ? (pos & 63) : (pos >> 6)) * 16 + i];
            const float t1 = bflo((unsigned)kr[0]), t2 = bflo((unsigned)kr[16]);
            kr[0] = (bf16_t)(pk2(t1 * cs.x - t2 * cs.y, 0.f) & 0xffffu); kr[16] = (bf16_t)(pk2(t2 * cs.x + t1 * cs.y, 0.f) & 0xffffu);
        }
    }
}

struct WJob { int in_idx, src_off, K, N, kind, pad; size_t dst; };
#define WJ_FFN(l) {8, (l) * DM * DFF, DM, DFF, 1, 0, WS_WGU(l)}, {9, (l) * DM * DFF, DM, DFF, 2, 0, WS_WGU(l)}, {10, (l) * DFF * DM, DFF, DM, 0, 0, WS_WD(l)}
__constant__ WJob kJobs[22] = {
    WJ_FFN(0), WJ_FFN(1), WJ_FFN(2), WJ_FFN(3),
    {11, 0, DM, 1536, 0, 0, WS_WA_QKV(0)}, {14, 0, DM, DM, 0, 0, WS_WA_O(0)}, {11, DM * 1536, DM, 1536, 0, 0, WS_WA_QKV(1)}, {14, DM * DM, DM, DM, 0, 0, WS_WA_O(1)},
    {15, 0, DM, 3072, 0, 0, WS_WB_QKV}, {17, 0, DM, DM, 0, 0, WS_WB_O},
    {18, 0, DM, 704, 0, 0, WS_WC_DQKV}, {21, 0, 384, 1536, 0, 0, WS_WC_UQ}, {22, 0, 256, 2048, 0, 0, WS_WC_UKV}, {23, 0, DM, DM, 0, 0, WS_WC_O}};
constexpr int NMOD_ITEMS = DEPTH * (MODW / 64);

DI void prologue_a(kaptr p, LAS unsigned char* lds, int wv) {
    const int tid = tidx(wv), lane = tid & 63, w = tid >> 6;
    LAS float* cond = (LAS float*)(lds);
    LAS float* red = (LAS float*)(lds + 20480);
    if (bidx() < NMOD_ITEMS) {
        for (int t = tid; t < 5 * DM; t += 512) { const float cv = t < 4 * DM ? KIN(p, 1)[t] : KIN(p, 3)[t - 4 * DM]; cond[t] = cv / (1.0f + __expf(-cv)); }
    }
    for (int it = bidx(); it < NMOD_ITEMS; it += gridDim.x) {
        __syncthreads();
        const int layer = it / (MODW / 64), n0 = (it - layer * (MODW / 64)) * 64;
        const float* wp = KIN(p, 4) + (size_t)layer * DM * MODW + (size_t)(128 * w) * MODW + n0 + lane;
        float acc[5] = {0.f, 0.f, 0.f, 0.f, 0.f};
#pragma unroll 16
        for (int k = 0; k < 128; ++k) { const float wv1 = wp[(size_t)k * MODW];
#pragma unroll
            for (int rI = 0; rI < 5; ++rI) acc[rI] += cond[rI * DM + 128 * w + k] * wv1; }
#pragma unroll
        for (int rI = 0; rI < 5; ++rI) red[(w * 5 + rI) * 64 + lane] = acc[rI];
        __syncthreads();
        if (tid < 320) { const int rI = tid >> 6; float sm = KIN(p, 5)[(size_t)layer * MODW + n0 + lane];
#pragma unroll
            for (int ww = 0; ww < 8; ++ww) sm += red[(ww * 5 + rI) * 64 + lane];
            ((float*)(KWS(p) + WS_MOD))[((size_t)layer * 5 + rI) * MODW + n0 + lane] = sm; }
    }
    {
        int nitem_total = 0;
        for (int j = 0; j < 22; ++j) nitem_total += (kJobs[j].K / 64) * (kJobs[j].N / 32);
        LAS float* scr = (LAS float*)(lds + 65536 + w * 8448);
        const int kr = lane >> 3, c4 = lane & 7, nrow = lane >> 1, hf = lane & 1;
        for (int it = bidx() * 8 + w; it < nitem_total; it += gridDim.x * 8) {
            int t = it, j = 0;
            for (; j < 21; ++j) { const int nt = (kJobs[j].K / 64) * (kJobs[j].N / 32); if (t < nt) break; t -= nt; }
            const WJob jb = kJobs[j];
            const int nblk = jb.N / 32, kb = t / nblk, nb = t - kb * nblk, k0 = 64 * kb, n0 = 32 * nb;
            const float* W = KIN(p, jb.in_idx) + jb.src_off + (size_t)(k0 + kr) * jb.N + n0 + 4 * c4;
            f32x4 v4[8];
#pragma unroll
            for (int i = 0; i < 8; ++i) v4[i] = *(const f32x4*)(W + (size_t)(8 * i) * jb.N);
#pragma unroll
            for (int i = 0; i < 8; ++i) { const int kk = 8 * i + kr; scr[(4 * c4 + 0) * 65 + kk] = v4[i].x; scr[(4 * c4 + 1) * 65 + kk] = v4[i].y; scr[(4 * c4 + 2) * 65 + kk] = v4[i].z; scr[(4 * c4 + 3) * 65 + kk] = v4[i].w; }
            asm volatile("s_waitcnt lgkmcnt(0)" ::: "memory");
            const int nn = n0 + nrow; const int drow = jb.kind == 0 ? nn : 256 * (nn >> 7) + (nn & 127) + (jb.kind == 2 ? 128 : 0);
            bf16_t* dp = (bf16_t*)(KWS(p) + jb.dst) + (size_t)drow * jb.K + k0 + 32 * hf;
#pragma unroll
            for (int q = 0; q < 4; ++q) {
                const LAS float* sp = scr + nrow * 65 + 32 * hf + 8 * q;
                u32x4 o; o.x = pk2(sp[0], sp[1]); o.y = pk2(sp[2], sp[3]); o.z = pk2(sp[4], sp[5]); o.w = pk2(sp[6], sp[7]);
                *(u32x4*)(dp + 8 * q) = o;
            }
            asm volatile("s_waitcnt lgkmcnt(0)" ::: "memory");
        }
    }
    const int gt = bidx() * 512 + tid, NGT = gridDim.x * 512;
    for (int t = gt; t < 64 * 32; t += NGT) { const int pos = t >> 5, i = t & 31; const float f = exp2f(-(float)(2 * i) * (1.0f / 64.0f) * 13.287712379549449f); float sn, cs; sincosf((float)pos * f, &sn, &cs); ((f32x2*)(KWS(p) + WS_ROPEA))[t] = (f32x2){cs, sn}; }
    for (int t = gt; t < 64 * 16; t += NGT) { const int pos = t >> 4, i = t & 15; const float f = exp2f(-(float)(2 * i) * (1.0f / 32.0f) * 13.287712379549449f); float sn, cs; sincosf((float)pos * f, &sn, &cs); ((f32x2*)(KWS(p) + WS_ROPEC))[t] = (f32x2){cs, sn}; }
    for (int t = gt; t < 64 * DM / 8; t += NGT) ((u32x4*)((bf16_t*)(KWS(p) + WS_WC_DQKV) + (size_t)704 * DM))[t] = (u32x4){0u, 0u, 0u, 0u};
    __syncthreads();
}

constexpr int NPHASES = 2 + 9 * DEPTH;
#if defined(PROBE_MASK)
#ifndef PROBE_LAYER
#define PROBE_LAYER -1
#endif
#define PROBE_SEL(k) ((k) < 2 ? ((PROBE_MASK >> (9 + (k))) & 1) : (((PROBE_MASK >> (((k) - 2) % 9)) & 1) && (PROBE_LAYER < 0 || ((k) - 2) / 9 == PROBE_LAYER)))
#define TSTART(k) if (PROBE_SEL(k)) tq0 = __builtin_amdgcn_s_memrealtime();
#define TSTOP(k) if (PROBE_SEL(k)) tacc += __builtin_amdgcn_s_memrealtime() - tq0;
#else
#define TSTART(k)
#define TSTOP(k)
#endif
#define PHASE_BEGIN(k) if (lo <= (k) && (k) < hi) { TSTART(k) kaptr p = (kaptr)__builtin_amdgcn_kernarg_segment_ptr(); asm volatile("" : "+s"(p)); unsigned char* ws = KWS(p); (void)ws;
#if defined(PROBE_SEAM2)
#define PHASE_END(k) if ((k) + 1 < hi) { gbar((unsigned*)(KWS(p) + WS_BAR), (LAS unsigned*)(lds + LDS_BYTES - 64), wv); gbar((unsigned*)(KWS(p) + WS_BAR), (LAS unsigned*)(lds + LDS_BYTES - 64), wv); } TSTOP(k) }
#else
#define PHASE_END(k) if ((k) + 1 < hi) gbar((unsigned*)(KWS(p) + WS_BAR), (LAS unsigned*)(lds + LDS_BYTES - 64), wv); TSTOP(k) }
#endif
#define XB_XCNT(j)  (256  + 64 * (j))
#define XB_XSUB(j)  (1280 + 64 * (j))
#define XB_XGEN(j)  (2304 + 64 * (j))
#define XB_TOP      3328
#define XB_TOPGEN   3392
#define XCD_BAR_WORDS 3456
DI unsigned xb_ld(unsigned* p_) { return __hip_atomic_load(p_, __ATOMIC_RELAXED, __HIP_MEMORY_SCOPE_AGENT); }
DI unsigned xb_add(unsigned* p_, unsigned v) { return __hip_atomic_fetch_add(p_, v, __ATOMIC_RELAXED, __HIP_MEMORY_SCOPE_AGENT); }
DI unsigned xb_xcc_id() { return (unsigned)__builtin_amdgcn_s_getreg((3 << 11) | 20) & 0xFu; }
DI void gbar(unsigned* bar, LAS unsigned* st, int wv) {
    asm volatile("s_waitcnt vmcnt(0)" ::: "memory");
    __syncthreads();
    if (tidx(wv) == 0) {
        __builtin_amdgcn_s_waitcnt(0);
        const unsigned x = xb_xcc_id();
        unsigned nloc = st[0], nx = st[1];
        if (nloc == 0u) {
            const unsigned G = gridDim.x;
            for (;;) { unsigned sum = 0u, cnt = 0u, mine = 0u;
#pragma unroll
                for (unsigned j = 0; j < 16; ++j) { const unsigned c = xb_ld(&bar[XB_XCNT(j)]); sum += c; cnt += (c > 0u) ? 1u : 0u; mine = (j == x) ? c : mine; }
                if (sum == G) { nloc = mine; nx = cnt; break; }
                __builtin_amdgcn_s_sleep(1); }
            st[0] = nloc; st[1] = nx;
        }
        const unsigned old = xb_add(&bar[XB_XSUB(x)], 1u);
        const unsigned gen = old / nloc;
        if (old + 1u == (gen + 1u) * nloc) {
            __builtin_amdgcn_fence(__ATOMIC_RELEASE, "agent");
            asm volatile("s_waitcnt vmcnt(0)" ::: "memory");
            const unsigned og = xb_add(&bar[XB_TOP], 1u);
            const unsigned tg = og / nx;
            if (og + 1u == (tg + 1u) * nx) xb_add(&bar[XB_TOPGEN], 1u);
            else while (xb_ld(&bar[XB_TOPGEN]) == tg) __builtin_amdgcn_s_sleep(1);
            __builtin_amdgcn_fence(__ATOMIC_ACQUIRE, "agent");
            xb_add(&bar[XB_XGEN(x)], 1u);
            asm volatile("s_waitcnt vmcnt(0)" ::: "memory");
        } else {
            while (xb_ld(&bar[XB_XGEN(x)]) == gen) __builtin_amdgcn_s_sleep(1);
            __builtin_amdgcn_fence(__ATOMIC_ACQUIRE, "agent");
            asm volatile("s_waitcnt vmcnt(0)" ::: "memory");
        }
    }
    __syncthreads();
}
template <int LAYER> DI void layer_phases(int lo, int hi, LAS unsigned char* lds, int wv, unsigned& nbar, unsigned long long& tacc) {
    unsigned long long tq0 = 0; (void)tq0;
    constexpr int kind = LAYER % 3, inst = LAYER / 3, P0 = 2 + 9 * LAYER; constexpr bool LASTL = LAYER == DEPTH - 1;
    constexpr size_t MODL = WS_MOD + (size_t)LAYER * 5 * MODW * 4;
    PHASE_BEGIN(P0 + 0)
        bf16_t* H = (bf16_t*)(ws + WS_H);
        if constexpr (kind == 0) { const EpiStore E = EpiStore::make((bf16_t*)(ws + WS_AQ), (bf16_t*)(ws + WS_AK), (bf16_t*)(ws + WS_AV), 1024, 1280, 1024, 256, 256, 1536);
            run_gemm(lds, wv, H, (const bf16_t*)(ws + WS_WA_QKV(inst)), MROWS, 1536, DM, E); }
        else if constexpr (kind == 1) { const EpiStore E = EpiStore::make((bf16_t*)(ws + WS_BQ), (bf16_t*)(ws + WS_BK), (bf16_t*)(ws + WS_BV), 1024, 2048, 1024, 1024, 1024, 3072);
            run_gemm(lds, wv, H, (const bf16_t*)(ws + WS_WB_QKV), MROWS, 3072, DM, E); }
        else { const EpiStore E = EpiStore::make((bf16_t*)(ws + WS_CQL), (bf16_t*)(ws + WS_CKVL), (bf16_t*)(ws + WS_CKR), 384, 640, 384, 256, 64, 704);
            run_gemm(lds, wv, H, (const bf16_t*)(ws + WS_WC_DQKV), MROWS, 768, DM, E); }
    PHASE_END(P0 + 0)
    if constexpr (kind == 0) { PHASE_BEGIN(P0 + 1) kpost_a(p, wv, KIN(p, 13) + inst * 128); PHASE_END(P0 + 1) }
    if constexpr (kind == 2) {
        PHASE_BEGIN(P0 + 1) post_c(p, wv, KIN(p, 19), KIN(p, 20)); PHASE_END(P0 + 1)
        PHASE_BEGIN(P0 + 2)
            { const EpiStore E = EpiStore::make((bf16_t*)(ws + WS_CQ), (bf16_t*)(ws + WS_CQ), (bf16_t*)(ws + WS_CQ), 0, 0, 1536, 1536, 1536, 1536);
              run_gemm(lds, wv, (const bf16_t*)(ws + WS_CQL), (const bf16_t*)(ws + WS_WC_UQ), MROWS, 1536, 384, E); }
            { const EpiStore E = EpiStore::make((bf16_t*)(ws + WS_CKV), (bf16_t*)(ws + WS_CKV), (bf16_t*)(ws + WS_CKV), 0, 0, 2048, 2048, 2048, 2048);
              run_gemm(lds, wv, (const bf16_t*)(ws + WS_CKVL), (const bf16_t*)(ws + WS_WC_UKV), MROWS, 2048, 256, E); }
        PHASE_END(P0 + 2)
    }
    PHASE_BEGIN(P0 + 3)
        bf16_t* H = (bf16_t*)(ws + WS_H);
#if defined(PROBE_ATT2)
        for (int rep_ = 0; rep_ < 2; ++rep_) { if (rep_) gbar((unsigned*)(ws + WS_BAR), (LAS unsigned*)(lds + LDS_BYTES - 64), wv);
#endif
        if constexpr (kind == 0) { const AttnArgs a{(const bf16_t*)(ws + WS_AQ), (const bf16_t*)(ws + WS_AK), (const bf16_t*)(ws + WS_AV), nullptr, H, KIN(p, 12) + inst * 128, nullptr, (const f32x2*)(ws + WS_ROPEA)}; attn_phase16(lds, a, wv, LAYER != DEPTH - 1); }
        else if constexpr (kind == 1) { const AttnArgs a{(const bf16_t*)(ws + WS_BQ), (const bf16_t*)(ws + WS_BK), (const bf16_t*)(ws + WS_BV), nullptr, H, nullptr, KIN(p, 16), nullptr}; attn_phase<1>(lds, a, wv, LAYER != DEPTH - 1); }
        else { const AttnArgs a{(const bf16_t*)(ws + WS_CQ), (const bf16_t*)(ws + WS_CKV), (const bf16_t*)(ws + WS_CKV), (const bf16_t*)(ws + WS_CKR), H, nullptr, nullptr, (const f32x2*)(ws + WS_ROPEC)}; attn_phase<2>(lds, a, wv, LAYER != DEPTH - 1); }
#if defined(PROBE_ATT2)
        }
#endif
    PHASE_END(P0 + 3)
    PHASE_BEGIN(P0 + 4)
        constexpr size_t WO = kind == 0 ? WS_WA_O(inst) : (kind == 1 ? WS_WB_O : WS_WC_O);
        const EpiResid E{(bf16_t*)(ws + WS_R), (float*)(ws + WS_PART)};
        run_gemm_lat(lds, wv, (const bf16_t*)(ws + WS_H), (const bf16_t*)(ws + WO), DM, DM, LASTL ? 0 : 4, E);
    PHASE_END(P0 + 4)
    PHASE_BEGIN(P0 + 5) rows_phase<true>(p, wv, KIN(p, 6) + (size_t)(LAYER * 2 + 0) * DM, KIN(p, 7) + (size_t)(LAYER * 2 + 0) * DM, (const float*)(ws + MODL) + 3 * DM, true, LASTL ? -1 : 4, (const float*)(ws + MODL) + 2 * DM, (const bf16_t*)(ws + WS_R), LAYER == 0); PHASE_END(P0 + 5)
    PHASE_BEGIN(P0 + 6) const EpiSwiGLU E{(bf16_t*)(ws + WS_ACT)};
#if defined(PROBE_UP2)
        run_gemm(lds, wv, (const bf16_t*)(ws + WS_H), (const bf16_t*)(ws + WS_WGU(LAYER)), MROWS, 2 * DFF, DM, E); gbar((unsigned*)(ws + WS_BAR), (LAS unsigned*)(lds + LDS_BYTES - 64), wv);
#endif
        if constexpr (LASTL) run_gemm_lat(lds, wv, (const bf16_t*)(ws + WS_H), (const bf16_t*)(ws + WS_WGU(LAYER)), 2 * DFF, DM, 0, E);
        else run_gemm(lds, wv, (const bf16_t*)(ws + WS_H), (const bf16_t*)(ws + WS_WGU(LAYER)), MROWS, 2 * DFF, DM, E);
    PHASE_END(P0 + 6)
    PHASE_BEGIN(P0 + 7) const EpiResid E{(bf16_t*)(ws + WS_H), (float*)(ws + WS_PART)};     run_gemm_lat(lds, wv, (const bf16_t*)(ws + WS_ACT), (const bf16_t*)(ws + WS_WD(LAYER)), DM, DFF, LASTL ? 0 : 11, E); PHASE_END(P0 + 7)
    PHASE_BEGIN(P0 + 8) constexpr bool last = LAYER == DEPTH - 1;
        rows_phase<true>(p, wv, KIN(p, 6) + (size_t)(LAYER * 2 + 1) * DM, KIN(p, 7) + (size_t)(LAYER * 2 + 1) * DM, (const float*)(ws + MODL) + (last ? 0 : 5 * MODW), !last, LASTL ? -1 : 11, (const float*)(ws + MODL) + 5 * DM, (const bf16_t*)(ws + WS_H)); PHASE_END(P0 + 8)
}
static bool phase_exists(int ph) {
    if (ph < 2) return true;
    const int layer = (ph - 2) / 9, step = (ph - 2) - layer * 9, kind = layer % 3;
    if (step == 1) return kind != 1;
    if (step == 2) return kind == 2;
    return true;
}

__global__ void __launch_bounds__(512, 2) mk_fwd(Params prm) {
    extern __shared__ __attribute__((aligned(16))) unsigned char lds_raw[];
    LAS unsigned char* lds = (LAS unsigned char*)lds_raw;
    const int wv = __builtin_amdgcn_readfirstlane((int)(threadIdx.x >> 6));
    const int lo = prm.ph_lo, hi = prm.ph_hi;
    unsigned nbar = 0; (void)nbar;
    if (threadIdx.x < 16) ((LAS unsigned*)(lds + LDS_BYTES - 64))[threadIdx.x] = 0u;
    if (threadIdx.x == 0 && hi - lo > 1) xb_add((unsigned*)(prm.ws + WS_BAR) + XB_XCNT(xb_xcc_id()), 1u);
    __syncthreads();
    unsigned long long tacc = 0, tq0 = 0; (void)tq0;
    if (lo <= 0 && 0 < hi) { TSTART(0) kaptr p = (kaptr)__builtin_amdgcn_kernarg_segment_ptr(); asm volatile("" : "+s"(p)); prologue_a(p, lds, wv);
        if (1 < hi) cg::this_grid().sync(); TSTOP(0) }
    PHASE_BEGIN(1) rows_phase<false>(p, wv, nullptr, nullptr, (const float*)(ws + WS_MOD), true); PHASE_END(1)
    layer_phases<0>(lo, hi, lds, wv, nbar, tacc);
    layer_phases<1>(lo, hi, lds, wv, nbar, tacc);
    layer_phases<2>(lo, hi, lds, wv, nbar, tacc);
    layer_phases<3>(lo, hi, lds, wv, nbar, tacc);
#if defined(PROBE_MASK)
    { const unsigned long long t1 = __builtin_amdgcn_s_memrealtime(); while (__builtin_amdgcn_s_memrealtime() - t1 < 4ull * tacc) __builtin_amdgcn_s_sleep(8); }
#endif
}

#ifndef MK_MULTI
#define MK_MULTI 0
#endif
extern "C" void kernel_launch(void* const* d_in, const int* in_sizes, int n_in, void* d_out, int out_size, void* d_ws, size_t ws_size, hipStream_t stream) {
    static int grid = 0;
    if (grid == 0) {
        if (n_in != 24 || out_size != NBATCH * SEQ * DM || ws_size < WS_END) { fprintf(stderr, "kernel_launch: unexpected shapes (n_in %d, out %d, ws %zu < %zu)\n", n_in, out_size, ws_size, (size_t)WS_END); grid = -1; return; }
        int dev = 0, cus = 0, per_cu = 0;
        hipGetDevice(&dev); hipDeviceGetAttribute(&cus, hipDeviceAttributeMultiprocessorCount, dev);
        if (hipFuncSetAttribute((const void*)mk_fwd, hipFuncAttributeMaxDynamicSharedMemorySize, LDS_BYTES) != hipSuccess) { fprintf(stderr, "kernel_launch: hipFuncSetAttribute failed\n"); grid = -1; return; }
        if (hipOccupancyMaxActiveBlocksPerMultiprocessor(&per_cu, (const void*)mk_fwd, 512, LDS_BYTES) != hipSuccess || per_cu < 1) { fprintf(stderr, "kernel_launch: occupancy query says %d\n", per_cu); per_cu = 1; }
        (void)hipGetLastError();
        grid = cus * per_cu;
    }
    if (grid < 0) return;
    Params p{};
    for (int i = 0; i < 24; ++i) p.in[i] = (const float*)d_in[i];
    p.out = (float*)d_out; p.ws = (unsigned char*)d_ws;
#if MK_MULTI
    for (int ph = 0; ph < NPHASES; ++ph) {
        if (!phase_exists(ph)) continue;
        p.ph_lo = ph; p.ph_hi = ph + 1;
        hipLaunchKernelGGL(mk_fwd, dim3(grid), dim3(512), LDS_BYTES, stream, p);
    }
#else
    p.ph_lo = 0; p.ph_hi = NPHASES;
    if (hipMemsetAsync((char*)d_ws + WS_BAR, 0, XCD_BAR_WORDS * 4, stream) != hipSuccess) { fprintf(stderr, "kernel_launch: memset of the barrier words failed\n"); return; }
    void* args[] = {&p};
    hipError_t e = hipLaunchCooperativeKernel((const void*)mk_fwd, dim3(grid), dim3(512), args, LDS_BYTES, stream);
    if (e != hipSuccess) fprintf(stderr, "cooperative launch failed: %s (grid %d)\n", hipGetErrorString(e), grid);
#endif
}
```

```cpp
#include <hip/hip_runtime.h>
#include <hip/hip_cooperative_groups.h>
#include <cstdio>
#include <cstdint>
namespace cg = cooperative_groups;
__device__ __forceinline__ int tidx(int wv) { int t = wv * 64 + (int)__builtin_amdgcn_mbcnt_hi(~0u, __builtin_amdgcn_mbcnt_lo(~0u, 0u)); asm volatile("" : "+v"(t)); return t; }
__device__ __forceinline__ int bidx() { int b = blockIdx.x; asm volatile("" : "+s"(b)); return b; }
namespace pg8 {
#define PG8_LAS __attribute__((address_space(3)))
typedef unsigned short bf16_t;
typedef short bf16x8 __attribute__((ext_vector_type(8)));
typedef float f32x4 __attribute__((ext_vector_type(4)));
typedef unsigned u32x4 __attribute__((ext_vector_type(4)));
constexpr int BM = 256, BK = 64, HALF = 128, HTB = HALF * BK * 2  , STAGE_BYTES = 8 * HTB, NXCD = 8, WGM = 8;

__host__ __device__ __forceinline__ int lds_byte(int r, int c) { const int st = (r >> 4) * 2 + (c >> 5), rr = r & 15, cc = c & 31, ob = rr * 64 + cc * 2; return st * 1024 + (ob ^ (((ob >> 9) & 1) << 5)); }
__host__ __device__ __forceinline__ void stage_rc(int b, int& R, int& C) { const int st = b / 1024, sb = b % 1024, swz = sb ^ (((sb >> 9) & 1) << 5); R = (st >> 1) * 16 + swz / 64; C = (st & 1) * 32 + (swz % 64) / 2; }
__host__ __device__ __forceinline__ int perm32(int rho) { const int n = rho >> 4, i = rho & 15; return 8 * (i >> 2) + 4 * n + (i & 3); }

struct Unit { int pm, pn, k0, nt, ks; };
struct Gemm { const bf16_t* A; const bf16_t* Bt; int M, N, K; };

struct StaticOrder {
    int nM, nN, nwg, G, c, ntk;
    __host__ __device__ void init(int M, int N, int G_, int c_) { nM = M / BM; nN = N / BM; nwg = nM * nN; G = G_; c = c_; }
    __host__ __device__ bool next(int i, Unit& u) const {
        const long L = (long)i * G + c; if (L >= nwg) return false;
        int wgid = (int)L; { const int q = nwg / NXCD, r = nwg % NXCD, xcd = wgid % NXCD, off = wgid / NXCD; wgid = (xcd < r ? xcd * (q + 1) : r * (q + 1) + (xcd - r) * q) + off; }
        const int nig = WGM * nN, gid = wgid / nig, fm = gid * WGM, gsz = (nM - fm) < WGM ? (nM - fm) : WGM;
        u.pm = fm + ((wgid % nig) % gsz); u.pn = (wgid % nig) / gsz; u.k0 = 0; u.nt = ntk; u.ks = -1; return true;
    }
    __device__ __forceinline__ void a_ready(const Unit&) const {}
    __device__ __forceinline__ void done(const Unit&) const {}
};
template <class Epi, class Sched, bool ALIGN_EPI = false, bool SP2 = false>
__device__ __forceinline__ void gemm_phase(PG8_LAS unsigned char* lds, const Gemm g, const Sched& S, const Epi& E, int wv) {
    const int tid = tidx(wv), wid = __builtin_amdgcn_readfirstlane(tid >> 6), lane = tid & 63, wr = wid >> 2, wc = wid & 3, fr = lane & 15, fq = lane >> 4;
    const int K = g.K;
    unsigned voffA[2], voffB[2];
#pragma unroll
    for (int i = 0; i < 2; ++i) { int R, C; stage_rc(tid * 16 + i * 8192, R, C); const int Rb = Epi::PERM ? ((R & ~31) + perm32(R & 31)) : R;
        voffA[i] = (unsigned)(R * K + C) * 2u; voffB[i] = (unsigned)(Rb * K + C) * 2u; }
    const size_t kstep = (size_t)(BK * 2);
    const size_t hstep = (size_t)HALF * K * 2;
    const size_t tstep = 2 * hstep;
    const unsigned ldsw = (unsigned)wid * 1024u;
    const int aoff = lds_byte(wr * 64 + fr, fq * 8), boff = lds_byte(wc * 32 + fr, fq * 8);
#define PG8_SA(b, h) (((b) * 2 + (h)) * HTB)
#define PG8_SB(b, h) ((4 + (b) * 2 + (h)) * HTB)
#define PG8_STAGE(bufoff, gbase, voff) do { _Pragma("unroll") for (int _i = 0; _i < 2; ++_i) \
        __builtin_amdgcn_global_load_lds((const unsigned*)((const char*)(gbase) + (voff)[_i]), (PG8_LAS unsigned*)(lds + (bufoff) + ldsw + _i * 8192), 16, 0, 0); } while (0)
#define PG8_LDA(dst, b, h) do { _Pragma("unroll") for (int m = 0; m < 4; ++m) _Pragma("unroll") for (int k = 0; k < 2; ++k) dst[m][k] = *(const PG8_LAS bf16x8*)(lds + PG8_SA(b, h) + aoff + m * 2048 + k * 1024); } while (0)
#define PG8_LDB(dst, b, h) do { _Pragma("unroll") for (int n = 0; n < 2; ++n) _Pragma("unroll") for (int k = 0; k < 2; ++k) dst[n][k] = *(const PG8_LAS bf16x8*)(lds + PG8_SB(b, h) + boff + n * 2048 + k * 1024); } while (0)
#define PG8_MMA(ai, bj, At, Bt) do { __builtin_amdgcn_s_setprio(1); _Pragma("unroll") for (int m = 0; m < 4; ++m) _Pragma("unroll") for (int n = 0; n < 2; ++n) _Pragma("unroll") for (int k = 0; k < 2; ++k) \
        acc[ai][bj][m][n] = __builtin_amdgcn_mfma_f32_16x16x32_bf16(Bt[n][k], At[m][k], acc[ai][bj][m][n], 0, 0, 0); __builtin_amdgcn_s_setprio(0); } while (0)
#define PG8_WAIT_V(n) asm volatile("s_waitcnt vmcnt(" #n ")" ::: "memory")
#define PG8_WAIT_L(n) asm volatile("s_waitcnt lgkmcnt(" #n ")" ::: "memory")
#define PG8_BAR __builtin_amdgcn_s_barrier()
#define PG8_SCHED __builtin_amdgcn_sched_barrier(0)
    Unit cur, nxt; int ui = 0;
    if (!S.next(0, cur)) return;
    f32x4 acc[2][2][4][2];
#pragma unroll
    for (int a = 0; a < 2; ++a)
#pragma unroll
        for (int b = 0; b < 2; ++b)
#pragma unroll
            for (int m = 0; m < 4; ++m)
#pragma unroll
                for (int n = 0; n < 2; ++n) acc[a][b][m][n] = (f32x4){0.f, 0.f, 0.f, 0.f};
    bf16x8 At[4][2], B0[2][2], B1[2][2];
    const char* cA = (const char*)g.A + (size_t)cur.pm * tstep + (size_t)cur.k0 * 2; const char* cB = (const char*)g.Bt + (size_t)cur.pn * tstep + (size_t)cur.k0 * 2;
    int nt = cur.nt;
    S.a_ready(cur);
    if constexpr (SP2) {
        PG8_STAGE(PG8_SB(0, 0), cB, voffB); PG8_STAGE(PG8_SB(0, 1), cB + hstep, voffB); PG8_STAGE(PG8_SA(0, 0), cA, voffA); PG8_STAGE(PG8_SA(0, 1), cA + hstep, voffA);
        if (wr == 1) PG8_BAR;
        PG8_WAIT_V(2); PG8_BAR;
        PG8_STAGE(PG8_SB(1, 0), cB + kstep, voffB); PG8_STAGE(PG8_SA(1, 0), cA + kstep, voffA); PG8_STAGE(PG8_SB(1, 1), cB + hstep + kstep, voffB);
        PG8_WAIT_V(6); PG8_BAR;
    } else {
        PG8_STAGE(PG8_SB(0, 0), cB, voffB); PG8_STAGE(PG8_SA(0, 0), cA, voffA); PG8_STAGE(PG8_SB(0, 1), cB + hstep, voffB); PG8_STAGE(PG8_SA(0, 1), cA + hstep, voffA);
        if (wr == 1) PG8_BAR;
        PG8_WAIT_V(4); PG8_BAR;
        PG8_STAGE(PG8_SB(1, 0), cB + kstep, voffB); PG8_STAGE(PG8_SA(1, 0), cA + kstep, voffA); PG8_STAGE(PG8_SB(1, 1), cB + hstep + kstep, voffB);
        PG8_WAIT_V(6); PG8_BAR;
    }
    for (;;) {
        const bool has_next = S.next(ui + 1, nxt);
        const char* nA = has_next ? (const char*)g.A + (size_t)nxt.pm * tstep + (size_t)nxt.k0 * 2 : cA; const char* nB = has_next ? (const char*)g.Bt + (size_t)nxt.pn * tstep + (size_t)nxt.k0 * 2 : cB;
        for (int t = 0; t < nt; t += 2) {
            const bool last = (t == nt - 2);
            const char* a1 = cA + (size_t)(t + 1) * kstep;
            const char* a2 = last ? nA : cA + (size_t)(t + 2) * kstep; const char* b2 = last ? nB : cB + (size_t)(t + 2) * kstep;
            const char* a3 = a2 + kstep; const char* b3 = b2 + kstep;
            if (last && has_next) S.a_ready(nxt);
            if constexpr (SP2) {
            PG8_LDB(B0, 0, 0); PG8_LDB(B1, 0, 1); PG8_SCHED; PG8_LDA(At, 0, 0); PG8_STAGE(PG8_SA(1, 1), a1 + hstep, voffA);
            PG8_WAIT_V(8); PG8_WAIT_L(0); PG8_BAR; PG8_MMA(0, 0, At, B0); PG8_MMA(0, 1, At, B1); PG8_BAR; PG8_SCHED;
            PG8_LDA(At, 0, 1); PG8_STAGE(PG8_SB(0, 0), b2, voffB); PG8_STAGE(PG8_SB(0, 1), b2 + hstep, voffB); PG8_STAGE(PG8_SA(0, 0), a2, voffA);
            PG8_WAIT_V(8); PG8_WAIT_L(0); PG8_BAR; PG8_MMA(1, 0, At, B0); PG8_MMA(1, 1, At, B1); PG8_BAR; PG8_SCHED;
            PG8_LDB(B0, 1, 0); PG8_LDB(B1, 1, 1); PG8_SCHED; PG8_LDA(At, 1, 0); PG8_STAGE(PG8_SA(0, 1), a2 + hstep, voffA);
            PG8_WAIT_V(8); PG8_WAIT_L(0); PG8_BAR; PG8_MMA(0, 0, At, B0); PG8_MMA(0, 1, At, B1); PG8_BAR; PG8_SCHED;
            PG8_LDA(At, 1, 1); PG8_STAGE(PG8_SB(1, 0), b3, voffB); PG8_STAGE(PG8_SB(1, 1), b3 + hstep, voffB); PG8_STAGE(PG8_SA(1, 0), a3, voffA);
            PG8_WAIT_V(8); PG8_WAIT_L(0); PG8_BAR; PG8_MMA(1, 0, At, B0); PG8_MMA(1, 1, At, B1); PG8_BAR; PG8_SCHED;
            } else {
            PG8_LDB(B0, 0, 0); PG8_SCHED; PG8_LDA(At, 0, 0); PG8_STAGE(PG8_SA(1, 1), a1 + hstep, voffA);
            PG8_WAIT_L(8); PG8_BAR; PG8_WAIT_L(0); PG8_MMA(0, 0, At, B0); PG8_BAR; PG8_SCHED;
            PG8_LDB(B1, 0, 1); PG8_STAGE(PG8_SB(0, 0), b2, voffB);
            PG8_BAR; PG8_WAIT_L(0); PG8_MMA(0, 1, At, B1); PG8_BAR;
            PG8_LDA(At, 0, 1); PG8_STAGE(PG8_SA(0, 0), a2, voffA);
            PG8_BAR; PG8_WAIT_L(0); PG8_MMA(1, 0, At, B0); PG8_BAR; PG8_SCHED;
            PG8_STAGE(PG8_SB(0, 1), b2 + hstep, voffB);
            PG8_WAIT_V(6); PG8_BAR; PG8_MMA(1, 1, At, B1); PG8_BAR;
            PG8_LDB(B0, 1, 0); PG8_SCHED; PG8_LDA(At, 1, 0); PG8_STAGE(PG8_SA(0, 1), a2 + hstep, voffA);
            PG8_WAIT_L(8); PG8_BAR; PG8_WAIT_L(0); PG8_MMA(0, 0, At, B0); PG8_BAR; PG8_SCHED;
            PG8_LDB(B1, 1, 1); PG8_STAGE(PG8_SB(1, 0), b3, voffB);
            PG8_BAR; PG8_WAIT_L(0); PG8_MMA(0, 1, At, B1); PG8_BAR;
            PG8_LDA(At, 1, 1); PG8_STAGE(PG8_SA(1, 0), a3, voffA);
            PG8_BAR; PG8_WAIT_L(0); PG8_MMA(1, 0, At, B0); PG8_BAR; PG8_SCHED;
            PG8_STAGE(PG8_SB(1, 1), b3 + hstep, voffB);
            PG8_WAIT_V(6); PG8_BAR; PG8_MMA(1, 1, At, B1); PG8_BAR;
            }
        }
        if constexpr (ALIGN_EPI) { if (wr == 0) PG8_BAR; }
        if constexpr (!Epi::AFTER_DRAIN) { E(acc, cur, wr, wc, fr, fq); S.done(cur); }
        if (!has_next) break;
#pragma unroll
        for (int a = 0; a < 2; ++a)
#pragma unroll
            for (int b = 0; b < 2; ++b)
#pragma unroll
                for (int m = 0; m < 4; ++m)
#pragma unroll
                    for (int n = 0; n < 2; ++n) acc[a][b][m][n] = (f32x4){0.f, 0.f, 0.f, 0.f};
        cur = nxt; cA = nA; cB = nB; ++ui; nt = cur.nt;
        if constexpr (ALIGN_EPI) { if (wr == 1) PG8_BAR; }
    }
    PG8_WAIT_V(0);
    if constexpr (!ALIGN_EPI) { if (wr == 0) PG8_BAR; }
    PG8_BAR;
    if constexpr (Epi::AFTER_DRAIN) { E.fused(acc, cur, wr, wc, fr, fq, lds, wid, lane); S.done(cur); }
#undef PG8_SA
#undef PG8_SB
#undef PG8_STAGE
#undef PG8_LDA
#undef PG8_LDB
#undef PG8_MMA
#undef PG8_WAIT_V
#undef PG8_WAIT_L
#undef PG8_BAR
#undef PG8_SCHED
}
}

#define LAS __attribute__((address_space(3)))
#define DI __device__ __forceinline__
using pg8::bf16_t; using pg8::bf16x8; using pg8::f32x4; using pg8::u32x4;
typedef short s16x4 __attribute__((ext_vector_type(4)));
typedef float f32x16 __attribute__((ext_vector_type(16)));
typedef float f32x2 __attribute__((ext_vector_type(2)));
typedef unsigned u32x2 __attribute__((ext_vector_type(2)));
typedef __bf16 bf16x2_t __attribute__((ext_vector_type(2)));

constexpr int NBATCH = 4, SEQ = 4096, CTXL = 256, TPB = 4352, MROWS = NBATCH * TPB, DM = 1024, DFF = 2816, DEPTH = 4, MODW = 6 * DM;
constexpr float ALPHA = 1.6817928305074290f, LOG2E = 1.4426950408889634f;
constexpr size_t MiB = 1048576;
constexpr size_t WS_MOD = 0, WS_ROPEA = 512 * 1024, WS_ROPEC = WS_ROPEA + 16384, WS_BAR = WS_ROPEC + 8192  , WS_XC = 1 * MiB, WS_H = 5 * MiB, WS_W = 39 * MiB;
constexpr size_t WS_WGU(int l) { return WS_W + (size_t)l * (33 * MiB / 2); }
constexpr size_t WS_WD(int l) { return WS_WGU(l) + 11 * MiB; }
constexpr size_t WS_WA_QKV(int j) { return WS_W + 66 * MiB + (size_t)j * 5 * MiB; }
constexpr size_t WS_WA_O(int j) { return WS_WA_QKV(j) + 3 * MiB; }
constexpr size_t WS_WB_QKV = WS_W + 76 * MiB, WS_WB_O = WS_WB_QKV + 6 * MiB;
constexpr size_t WS_WC_DQKV = WS_W + 84 * MiB, WS_WC_UQ = WS_WC_DQKV + 3 * MiB / 2, WS_WC_UKV = WS_WC_UQ + 9 * MiB / 8, WS_WC_O = WS_WC_UKV + 1 * MiB;
constexpr size_t WS_R = 129 * MiB;
constexpr size_t WS_AQ = WS_R, WS_AK = WS_R + 34 * MiB, WS_AV = WS_AK + 17 * MiB / 2;
constexpr size_t WS_BQ = WS_R, WS_BK = WS_R + 34 * MiB, WS_BV = WS_R + 68 * MiB;
constexpr size_t WS_CQ = WS_R, WS_CKV = WS_R + 51 * MiB, WS_CKR = WS_R + 119 * MiB, WS_CQL = WS_R + 122 * MiB, WS_CKVL = WS_R + 135 * MiB;
constexpr size_t WS_ACT = WS_R, WS_PART = WS_R + 96 * MiB  ;
constexpr size_t WS_END = WS_R + 144 * MiB;
static_assert(WS_WC_O + 2 * MiB <= WS_R, "weights fit");

constexpr int LDS_BYTES = 147456;

struct Params { const float* in[24]; float* out; unsigned char* ws; int ph_lo, ph_hi; };
typedef const __attribute__((address_space(4))) unsigned char* kaptr;
DI const float* KIN(kaptr ka, int i) { return *(const float* const __attribute__((address_space(4)))*)(ka + 8 * i); }
DI float* KOUT(kaptr ka) { return *(float* const __attribute__((address_space(4)))*)(ka + 192); }
DI unsigned char* KWS(kaptr ka) { return *(unsigned char* const __attribute__((address_space(4)))*)(ka + 200); }

DI unsigned pk2(float lo, float hi) { f32x2 v = {lo, hi}; return __builtin_bit_cast(unsigned, __builtin_convertvector(v, bf16x2_t)); }
DI float bflo(unsigned u) { return __uint_as_float(u << 16); }
DI float bfhi(unsigned u) { return __uint_as_float(u & 0xffff0000u); }
DI void unpack8(const u32x4 w, float (&f)[8]) { f[0] = bflo(w.x); f[1] = bfhi(w.x); f[2] = bflo(w.y); f[3] = bfhi(w.y); f[4] = bflo(w.z); f[5] = bfhi(w.z); f[6] = bflo(w.w); f[7] = bfhi(w.w); }
DI u32x4 pack8(const float (&f)[8]) { u32x4 w; w.x = pk2(f[0], f[1]); w.y = pk2(f[2], f[3]); w.z = pk2(f[4], f[5]); w.w = pk2(f[6], f[7]); return w; }
DI float wave_sum(float v) {
#pragma unroll
    for (int o = 1; o < 64; o <<= 1) v += __shfl_xor(v, o);
    return v;
}
DI float silu_f(float x) { return x * __builtin_amdgcn_rcpf(1.0f + __expf(-x)); }

struct EpiStore {
    static constexpr bool PERM = true, AFTER_DRAIN = false;
    bf16_t* p2; long long d12, d01; int ld2, dl12, dl01, c1, c2, nvalid;
    static DI EpiStore make(bf16_t* p0, bf16_t* p1, bf16_t* p2, int c1, int c2, int ld0, int ld1, int ld2, int nvalid) {
        EpiStore e; e.p2 = p2; e.d12 = (long long)(p1 - p2); e.d01 = (long long)(p0 - p1); e.ld2 = ld2; e.dl12 = ld1 - ld2; e.dl01 = ld0 - ld1; e.c1 = c1; e.c2 = c2; e.nvalid = nvalid; return e; }
    DI void operator()(const f32x4 (&acc)[2][2][4][2], const pg8::Unit& u, int wr, int wc, int fr, int fq) const {
        const int row0 = u.pm * 256 + wr * 64 + fr;
#pragma unroll
        for (int bj = 0; bj < 2; ++bj) {
            const int col = u.pn * 256 + bj * 128 + wc * 32 + 8 * fq;
            const int m0 = -(int)(col < c1), m1 = -(int)(col < c2);
            bf16_t* base = p2 + ((d12 & (long long)m1) + (d01 & (long long)m0));
            const int ld = ld2 + (dl12 & m1) + (dl01 & m0), lc = col - c2 + ((c2 - c1) & m1) + (c1 & m0);
            if (col < nvalid) {
#pragma unroll
                for (int ai = 0; ai < 2; ++ai)
#pragma unroll
                    for (int m = 0; m < 4; ++m) {
                        const f32x4 v0 = acc[ai][bj][m][0], v1 = acc[ai][bj][m][1];
                        u32x4 w; w.x = pk2(v0[0], v0[1]); w.y = pk2(v0[2], v0[3]); w.z = pk2(v1[0], v1[1]); w.w = pk2(v1[2], v1[3]);
                        *(u32x4*)(base + (size_t)(row0 + ai * 128 + m * 16) * ld + lc) = w;
                    }
            }
        }
    }
};
struct EpiResid {
    static constexpr bool PERM = true, AFTER_DRAIN = false;
    bf16_t* Y; float* part;
    DI void operator()(const f32x4 (&acc)[2][2][4][2], const pg8::Unit& u, int wr, int wc, int fr, int fq) const {
        const int rl = wr * 64 + fr;
        if (u.ks >= 0) {
            const int b = u.pm / 17;
            float* pb = part + ((size_t)u.ks * 1024 + (size_t)b * 256) * DM;
#pragma unroll
            for (int bj = 0; bj < 2; ++bj) {
                const int col = u.pn * 256 + bj * 128 + wc * 32 + 8 * fq;
#pragma unroll
                for (int ai = 0; ai < 2; ++ai)
#pragma unroll
                    for (int m = 0; m < 4; ++m) {
                        float* xp = pb + (size_t)(rl + ai * 128 + m * 16) * DM + col;
                        *(f32x4*)xp = acc[ai][bj][m][0]; *(f32x4*)(xp + 4) = acc[ai][bj][m][1];
                    }
            }
            return;
        }
        bf16_t* yb = Y + (size_t)(u.pm * 256 + rl) * DM;
#pragma unroll
        for (int bj = 0; bj < 2; ++bj) {
            const int col = u.pn * 256 + bj * 128 + wc * 32 + 8 * fq;
#pragma unroll
            for (int ai = 0; ai < 2; ++ai)
#pragma unroll
                for (int m = 0; m < 4; ++m) {
                    const f32x4 v0 = acc[ai][bj][m][0], v1 = acc[ai][bj][m][1];
                    u32x4 w; w.x = pk2(v0[0], v0[1]); w.y = pk2(v0[2], v0[3]); w.z = pk2(v1[0], v1[1]); w.w = pk2(v1[2], v1[3]);
                    *(u32x4*)(yb + (size_t)(ai * 128 + m * 16) * DM + col) = w;
                }
        }
    }
};
struct EpiSwiGLU {
    static constexpr bool PERM = true, AFTER_DRAIN = false;
    bf16_t* act;
    DI void operator()(const f32x4 (&acc)[2][2][4][2], const pg8::Unit& u, int wr, int wc, int fr, int fq) const {
        const int row0 = u.pm * 256 + wr * 64 + fr, col = u.pn * 128 + wc * 32 + 8 * fq;
#pragma unroll
        for (int ai = 0; ai < 2; ++ai)
#pragma unroll
            for (int m = 0; m < 4; ++m) {
                const f32x4 a0 = acc[ai][0][m][0], a1 = acc[ai][0][m][1], b0 = acc[ai][1][m][0], b1 = acc[ai][1][m][1];
                u32x4 w;
                w.x = pk2(silu_f(a0[0]) * b0[0], silu_f(a0[1]) * b0[1]); w.y = pk2(silu_f(a0[2]) * b0[2], silu_f(a0[3]) * b0[3]);
                w.z = pk2(silu_f(a1[0]) * b1[0], silu_f(a1[1]) * b1[1]); w.w = pk2(silu_f(a1[2]) * b1[2], silu_f(a1[3]) * b1[3]);
                *(u32x4*)(act + (size_t)(row0 + ai * 128 + m * 16) * DFF + col) = w;
            }
    }
};
template <class Epi> DI void run_gemm(LAS unsigned char* lds, int wv, const bf16_t* A, const bf16_t* Bt, int M, int N, int K, const Epi& E) {
    pg8::Gemm g{A, Bt, M, N, K}; pg8::StaticOrder S; S.init(M, N, (int)gridDim.x, bidx()); S.ntk = K / 64;
    pg8::gemm_phase<Epi, pg8::StaticOrder, true, true>(lds, g, S, E, wv);
}
struct LatCtxOrder {
    pg8::StaticOrder so; int KS, nsplit, G, c;
    DI void init(int N, int K, int KS_, int G_, int c_) { so.init(NBATCH * SEQ, N, G_, c_); so.ntk = K / 64; KS = KS_; nsplit = 4 * (N / 256) * KS_; G = G_; c = c_; }
    DI bool next(int i, pg8::Unit& u) const {
        const int L = i * G + c;
        if (L < so.nwg) { so.next(i, u); u.pm += u.pm >> 4; return true; }
        const int s = L - so.nwg; if (s >= nsplit) return false;
        const int kp = s % KS, u16 = s / KS, nN = so.nN;
        u.pm = 17 * (u16 / nN) + 16; u.pn = u16 % nN; u.nt = so.ntk / KS; u.k0 = kp * u.nt * 64; u.ks = kp; return true;
    }
    DI void a_ready(const pg8::Unit&) const {}
    DI void done(const pg8::Unit&) const {}
};
template <class Epi> DI void run_gemm_lat(LAS unsigned char* lds, int wv, const bf16_t* A, const bf16_t* Bt, int N, int K, int KS, const Epi& E) {
    pg8::Gemm g{A, Bt, MROWS, N, K}; LatCtxOrder S; S.init(N, K, KS, (int)gridDim.x, bidx());
    pg8::gemm_phase<Epi, LatCtxOrder, true, true>(lds, g, S, E, wv);
}

struct AttnArgs { const bf16_t* Q; const bf16_t* K; const bf16_t* V; const bf16_t* K2; bf16_t* O; const float* gain; const float* rpb; const f32x2* rope; };
DI int crow(int i, int h) { return (i & 3) + 8 * (i >> 2) + 4 * h; }

template <int MODE> DI void attn_phase(LAS unsigned char* lds, const AttnArgs a, int wv, bool with_ctx) {
    constexpr int DK = MODE == 0 ? 128 : (MODE == 1 ? 64 : 192), DV = MODE == 1 ? 64 : 128;
    constexpr int KT = MODE == 2 ? 192 : 128, VT = 128;
    constexpr int KSTR = KT * 2 + 16, VSTR = VT * 2 + 64, VOFF = 64 * KSTR, BOFF = VOFF + 64 * VSTR;
    constexpr int KCH = KT / 8, VCH = VT / 8, NKC = KT / 64, NVC = VT / 64, NS = DK / 16, NVB = DV / 32;
    constexpr int QLD = MODE == 2 ? 1536 : 1024;
    constexpr float QS = (MODE == 0 ? 0.08838834764831845f : (MODE == 1 ? 0.125f : 0.07216878364870322f)) * LOG2E;
    const int tid = tidx(wv), w = __builtin_amdgcn_readfirstlane(tid >> 6);
    const int nunits = MODE == 1 ? (with_ctx ? 1088 : 1024) : (with_ctx ? 544 : 512);
    const int kc0 = MODE == 1 ? 64 * ((w >> 1) & 1) : 0;
    for (int it_ = bidx(); it_ < nunits; it_ += gridDim.x) {
        int u = it_;
        if (MODE != 1 && gridDim.x == 256 && it_ < 512) u = (((it_ >> 8) * 8 + (it_ & 7)) * 32) + ((it_ >> 3) & 31);
        int tu_ = tid; asm volatile("" : "+v"(tu_));
        const int lane = tu_ & 63, r = lane & 31, h = lane >> 5;
        int b, head, hq = 0, qpos, nloc, base0, ntiles, rr = 0, rs = 0, rs0 = 0;
        if (MODE == 1) {
            if (u < 1024) { b = u >> 8; const int rp = (u >> 3) & 31; hq = u & 7; rr = 2 * rp + (w >> 2); qpos = rr * 64 + 32 * (w & 1) + r;
                const int rsA = min(max(2 * rp - 4, 0), 56), rsB = min(max(2 * rp - 3, 0), 56); rs = (w >> 2) ? rsB : rsA; rs0 = rsA; nloc = rsB - rsA + 8; base0 = rsA * 64; ntiles = nloc + 4; }
            else { const int v = u - 1024; b = v >> 4; hq = v & 7; qpos = 4096 + (2 * ((v >> 3) & 1) + (w >> 2)) * 64 + 32 * (w & 1) + r; nloc = 0; base0 = 0; ntiles = 4; }
            head = 2 * hq + ((w >> 1) & 1);
        } else {
            if (u < 512) { b = u >> 7; head = (u >> 4) & 7; qpos = (u & 15) * 256 + 32 * w + r; nloc = 68; base0 = 0; ntiles = 68; }
            else { const int v = u - 512; b = v >> 3; head = v & 7; qpos = 4096 + 32 * w + r; nloc = 0; base0 = 0; ntiles = 4; }
        }
        const int kvh = head >> 2;
        const size_t rowb = (size_t)b * TPB;
        const bool lat = qpos < 4096;
        bf16x8 qf[NS];
        {
            const bf16_t* qp = a.Q + (rowb + qpos) * QLD + head * DK + 8 * h;
            u32x4 qraw[NS];
#pragma unroll
            for (int s = 0; s < NS; ++s) qraw[s] = *(const u32x4*)(qp + 16 * s);
            if (MODE == 0) {
                float ss = 0.f;
#pragma unroll
                for (int s = 0; s < NS; ++s) { float f[8]; unpack8(qraw[s], f);
#pragma unroll
                    for (int e = 0; e < 8; ++e) ss += f[e] * f[e]; }
                ss += __shfl_xor(ss, 32);
                const float rstd = rsqrtf(ss * (1.0f / 128.0f) + 1e-6f) * QS;
                const int pr = qpos >> 6, pc = qpos & 63;
#pragma unroll
                for (int g = 0; g < 4; ++g) {
                    const int s0 = (g & 1) + 4 * (g >> 1), s1 = s0 + 2, pos = (g >> 1) ? pc : pr, i0 = 16 * (g & 1) + 8 * h;
                    float t1[8], t2[8], o1[8], o2[8]; unpack8(qraw[s0], t1); unpack8(qraw[s1], t2);
                    const float* g1 = a.gain + 16 * s0 + 8 * h; const float* g2 = a.gain + 16 * s1 + 8 * h;
#pragma unroll
                    for (int e = 0; e < 8; ++e) {
                        f32x2 cs = a.rope[pos * 32 + i0 + e]; if (!lat) { cs.x = 1.f; cs.y = 0.f; }
                        const float x1 = t1[e] * rstd * g1[e], x2 = t2[e] * rstd * g2[e];
                        o1[e] = x1 * cs.x - x2 * cs.y; o2[e] = x2 * cs.x + x1 * cs.y;
                    }
                    qraw[s0] = pack8(o1); qraw[s1] = pack8(o2);
                    asm volatile("" ::: "memory");
                }
            } else if (MODE == 1) {
#pragma unroll
                for (int s = 0; s < NS; ++s) { float f[8]; unpack8(qraw[s], f);
#pragma unroll
                    for (int e = 0; e < 8; ++e) f[e] *= QS;
                    qraw[s] = pack8(f); }
            } else {
#pragma unroll
                for (int s = 0; s < 8; ++s) { float f[8]; unpack8(qraw[s], f);
#pragma unroll
                    for (int e = 0; e < 8; ++e) f[e] *= QS;
                    qraw[s] = pack8(f); }
#ifndef EXP_NOROPE2
                const int pr = qpos >> 6, pc = qpos & 63;
#pragma unroll
                for (int g = 0; g < 2; ++g) {
                    const int s0 = 8 + 2 * g, s1 = s0 + 1, pos = g ? pc : pr;
                    float t1[8], t2[8], o1[8], o2[8]; unpack8(qraw[s0], t1); unpack8(qraw[s1], t2);
#pragma unroll
                    for (int e = 0; e < 8; ++e) {
                        f32x2 cs = a.rope[pos * 16 + 8 * h + e]; if (!lat) { cs.x = 1.f; cs.y = 0.f; }
                        const float x1 = t1[e] * QS, x2 = t2[e] * QS;
                        o1[e] = x1 * cs.x - x2 * cs.y; o2[e] = x2 * cs.x + x1 * cs.y;
                    }
                    qraw[s0] = pack8(o1); qraw[s1] = pack8(o2);
                    asm volatile("" ::: "memory");
                }
#endif
            }
#pragma unroll
            for (int s = 0; s < NS; ++s) qf[s] = __builtin_bit_cast(bf16x8, qraw[s]);
        }
        __syncthreads();
        if (MODE == 1 && nloc > 0) {
            LAS float* bl = (LAS float*)(lds + BOFF);
            for (int t = tid; t < 2 * 465; t += 512) bl[t] = a.rpb[(size_t)(2 * hq) * 465 + t] * LOG2E;
        }
        f32x16 oacc[NVB];
#pragma unroll
        for (int vb = 0; vb < NVB; ++vb)
#pragma unroll
            for (int i = 0; i < 16; ++i) oacc[vb][i] = 0.f;
        float mrun = 0.f, lrun = 0.f;
        u32x4 kreg[NKC], vreg[NVC];
#define ATT_LOAD_TILE(kp) do { \
        _Pragma("unroll") for (int i_ = 0; i_ < NKC; ++i_) { const int ci = tl_ + 512 * i_, kr = ci / KCH, cc = ci - kr * KCH; const size_t row = rowb + (kp) + kr; const bf16_t* src; \
            if (MODE == 0) src = a.K + row * 256 + kvh * 128 + cc * 8; else if (MODE == 1) src = a.K + row * 1024 + hq * 128 + cc * 8; \
            else src = (cc < 16) ? a.K + row * 2048 + head * 256 + cc * 8 : a.K2 + row * 64 + (cc - 16) * 8; \
            kreg[i_] = *(const u32x4*)src; } \
        _Pragma("unroll") for (int i_ = 0; i_ < NVC; ++i_) { const int ci = tl_ + 512 * i_, kr = ci / VCH, cc = ci - kr * VCH; const size_t row = rowb + (kp) + kr; const bf16_t* src; \
            if (MODE == 0) src = a.V + row * 256 + kvh * 128 + cc * 8; else if (MODE == 1) src = a.V + row * 1024 + hq * 128 + cc * 8; \
            else src = a.V + row * 2048 + head * 256 + 128 + cc * 8; \
            vreg[i_] = *(const u32x4*)src; } } while (0)
        { int tl_ = tid; asm volatile("" : "+v"(tl_)); ATT_LOAD_TILE(nloc > 0 ? base0 : 4096); }
        for (int j = 0; j < ntiles; ++j) {
            int tl_ = tid; asm volatile("" : "+v"(tl_));
            const int ln_ = tl_ & 63, r = ln_ & 31, h = ln_ >> 5;
            __syncthreads();
#pragma unroll
            for (int i_ = 0; i_ < NKC; ++i_) { const int ci = tl_ + 512 * i_, kr = ci / KCH, cc = ci - kr * KCH; *(LAS u32x4*)(lds + kr * KSTR + cc * 16) = kreg[i_]; }
#pragma unroll
            for (int i_ = 0; i_ < NVC; ++i_) { const int ci = tl_ + 512 * i_, kr = ci / VCH, cc = ci - kr * VCH; *(LAS u32x4*)(lds + VOFF + kr * VSTR + cc * 16) = vreg[i_]; }
            __syncthreads();
            if (j + 1 < ntiles) { const int jn = j + 1; const int kpn = jn < nloc ? base0 + 64 * jn : 4096 + 64 * (jn - nloc); ATT_LOAD_TILE(kpn); }
            if (!(MODE == 1 && j < nloc && (rs0 + j < rs || rs0 + j > rs + 7))) {
            f32x16 sacc[2];
#pragma unroll
            for (int kb = 0; kb < 2; ++kb)
#pragma unroll
                for (int i = 0; i < 16; ++i) sacc[kb][i] = -mrun;
#pragma unroll
            for (int s = 0; s < NS; ++s) {
#pragma unroll
                for (int kb = 0; kb < 2; ++kb) {
                    const bf16x8 kf = *(const LAS bf16x8*)(lds + (32 * kb + r) * KSTR + (kc0 + 16 * s + 8 * h) * 2);
                    sacc[kb] = __builtin_amdgcn_mfma_f32_32x32x16_bf16(kf, qf[s], sacc[kb], 0, 0, 0);
                }
                if ((s & 1) == 1) asm volatile("" ::: "memory");
            }
            if (MODE == 1 && j < nloc) {
                const int c = qpos & 63, cs = min(max(c - 8, 0), 48), dr = rs0 + j - rr + 7;
                const LAS float* bl = (const LAS float*)(lds + BOFF) + (((w >> 1) & 1) * 15 + dr) * 31 + 15 - c;
#pragma unroll
                for (int kb = 0; kb < 2; ++kb) {
#pragma unroll
                    for (int i = 0; i < 16; ++i) {
                        const int jc = 32 * kb + crow(i, h); const bool ok = (unsigned)(jc - cs) < 16u;
                        const float bias = bl[ok ? jc : c];
                        sacc[kb][i] = ok ? sacc[kb][i] + bias : -1e30f;
                        if ((i & 7) == 7) asm volatile("" ::: "memory");
                    }
                }
            }
            float mx = sacc[0][0];
#pragma unroll
            for (int kb = 0; kb < 2; ++kb)
#pragma unroll
                for (int i = 0; i < 16; ++i) mx = fmaxf(mx, sacc[kb][i]);
            mx = fmaxf(mx, __shfl_xor(mx, 32));
            if (!__all(mx <= 8.0f)) {
                const float d = fmaxf(mx, 0.f), alpha = __builtin_amdgcn_exp2f(-d);
                mrun += d; lrun *= alpha;
#pragma unroll
                for (int vb = 0; vb < NVB; ++vb)
#pragma unroll
                    for (int i = 0; i < 16; ++i) oacc[vb][i] *= alpha;
#pragma unroll
                for (int kb = 0; kb < 2; ++kb)
#pragma unroll
                    for (int i = 0; i < 16; ++i) sacc[kb][i] -= d;
            }
            f32x2 sum2 = {0.f, 0.f};
#pragma unroll
            for (int kb = 0; kb < 2; ++kb)
#pragma unroll
                for (int i = 0; i < 16; i += 2) {
                    f32x2 pp; pp.x = __builtin_amdgcn_exp2f(sacc[kb][i]); pp.y = __builtin_amdgcn_exp2f(sacc[kb][i + 1]);
                    sacc[kb][i] = pp.x; sacc[kb][i + 1] = pp.y; sum2 += pp;
                }
            float sum = sum2.x + sum2.y;
            asm volatile("" : "+v"(sum));
            lrun += sum;
            bf16x8 pf[4];
#pragma unroll
            for (int t = 0; t < 4; ++t) {
                const int kb = t >> 1, o = 8 * (t & 1);
                u32x4 pw; pw.x = pk2(sacc[kb][o], sacc[kb][o + 1]); pw.y = pk2(sacc[kb][o + 2], sacc[kb][o + 3]); pw.z = pk2(sacc[kb][o + 4], sacc[kb][o + 5]); pw.w = pk2(sacc[kb][o + 6], sacc[kb][o + 7]);
                pf[t] = __builtin_bit_cast(bf16x8, pw);
            }
            {
                const int i16 = ln_ & 15, q4 = i16 >> 2, p4 = i16 & 3, g1 = (ln_ >> 4) & 1;
                LAS unsigned char* vbase = lds + VOFF + (4 * h + q4) * VSTR + (kc0 + 16 * g1) * 2 + 8 * p4;
#pragma unroll
                for (int t = 0; t < 4; ++t) {
#pragma unroll
                    for (int vb = 0; vb < NVB; ++vb) {
                        const s16x4 lo = __builtin_amdgcn_ds_read_tr16_b64_v4i16((LAS s16x4*)(vbase + (16 * t) * VSTR + 64 * vb));
                        const s16x4 hi = __builtin_amdgcn_ds_read_tr16_b64_v4i16((LAS s16x4*)(vbase + (16 * t + 8) * VSTR + 64 * vb));
                        const bf16x8 va = __builtin_shufflevector(lo, hi, 0, 1, 2, 3, 4, 5, 6, 7);
                        oacc[vb] = __builtin_amdgcn_mfma_f32_32x32x16_bf16(va, pf[t], oacc[vb], 0, 0, 0);
                    }
                    asm volatile("" ::: "memory");
                }
            }
            }
        }
#undef ATT_LOAD_TILE
        {
            lrun += __shfl_xor(lrun, 32);
            const float inv = 1.0f / lrun;
            bf16_t* op = a.O + (rowb + qpos) * 1024 + head * DV + 4 * h;
#pragma unroll
            for (int vb = 0; vb < NVB; ++vb)
#pragma unroll
                for (int g = 0; g < 4; ++g) {
                    u32x2 wv; wv.x = pk2(oacc[vb][4 * g] * inv, oacc[vb][4 * g + 1] * inv); wv.y = pk2(oacc[vb][4 * g + 2] * inv, oacc[vb][4 * g + 3] * inv);
                    *(u32x2*)(op + 32 * vb + 8 * g) = wv;
                }
        }
    }
    __syncthreads();
}

DI void attn_phase16(LAS unsigned char* lds, const AttnArgs a, int wv, bool with_ctx) {
    constexpr int KSTR = 288, VSTR = 288, VOFF = 64 * KSTR;
    constexpr int KCH = 16, VCH = 16, NKC = 2, NVC = 2;
    constexpr float QS = 0.08838834764831845f * LOG2E;
    const int tid = tidx(wv), w = __builtin_amdgcn_readfirstlane(tid >> 6);
    const int nunits = with_ctx ? 544 : 512;
    for (int it_ = bidx(); it_ < nunits; it_ += gridDim.x) {
        int u = it_;
        if (gridDim.x == 256 && it_ < 512) u = (((it_ >> 8) * 8 + (it_ & 7)) * 32) + ((it_ >> 3) & 31);
        int tu_ = tid; asm volatile("" : "+v"(tu_));
        const int lane = tu_ & 63, c = lane & 15, g = lane >> 4;
        int b, head, q0, ntiles, kbase0;
        if (u < 512) { b = u >> 7; head = (u >> 4) & 7; q0 = (u & 15) * 256 + 32 * w; ntiles = 68; kbase0 = 0; }
        else { const int v = u - 512; b = v >> 3; head = v & 7; q0 = 4096 + 32 * w; ntiles = 4; kbase0 = 4096; }
        const int kvh = head >> 2;
        const size_t rowb = (size_t)b * TPB;
        const bool lat = q0 < 4096;
        bf16x8 qf[2][4];
#pragma unroll
        for (int qb = 0; qb < 2; ++qb) {
            const int qpos = q0 + 16 * qb + c;
            const bf16_t* qp = a.Q + (rowb + qpos) * 1024 + head * 128 + 8 * g;
            u32x4 qraw[4];
#pragma unroll
            for (int s = 0; s < 4; ++s) qraw[s] = *(const u32x4*)(qp + 32 * s);
            float ss = 0.f;
#pragma unroll
            for (int s = 0; s < 4; ++s) { float f[8]; unpack8(qraw[s], f);
#pragma unroll
                for (int e = 0; e < 8; ++e) ss += f[e] * f[e]; }
            ss += __shfl_xor(ss, 16); ss += __shfl_xor(ss, 32);
            const float rstd = rsqrtf(ss * (1.0f / 128.0f) + 1e-6f) * QS;
            const int pr = qpos >> 6, pc = qpos & 63;
#pragma unroll
            for (int gg = 0; gg < 2; ++gg) {
                const int s0 = 2 * gg, s1 = s0 + 1, pos = gg ? pc : pr;
                float t1[8], t2[8], o1[8], o2[8]; unpack8(qraw[s0], t1); unpack8(qraw[s1], t2);
                const float* g1 = a.gain + 32 * s0 + 8 * g; const float* g2 = a.gain + 32 * s1 + 8 * g;
#pragma unroll
                for (int e = 0; e < 8; ++e) {
                    f32x2 cs = a.rope[pos * 32 + 8 * g + e]; if (!lat) { cs.x = 1.f; cs.y = 0.f; }
                    const float x1 = t1[e] * rstd * g1[e], x2 = t2[e] * rstd * g2[e];
                    o1[e] = x1 * cs.x - x2 * cs.y; o2[e] = x2 * cs.x + x1 * cs.y;
                }
                qraw[s0] = pack8(o1); qraw[s1] = pack8(o2);
                asm volatile("" ::: "memory");
            }
#pragma unroll
            for (int s = 0; s < 4; ++s) qf[qb][s] = __builtin_bit_cast(bf16x8, qraw[s]);
        }
        __syncthreads();
        f32x4 oacc[2][8];
#pragma unroll
        for (int qb = 0; qb < 2; ++qb)
#pragma unroll
            for (int vb = 0; vb < 8; ++vb) oacc[qb][vb] = (f32x4){0.f, 0.f, 0.f, 0.f};
        float mrun[2] = {0.f, 0.f}, lrun[2] = {0.f, 0.f};
        u32x4 kreg[NKC], vreg[NVC];
#define A16_LOAD(kp) do { \
        _Pragma("unroll") for (int i_ = 0; i_ < NKC; ++i_) { const int ci = tl_ + 512 * i_, kr = ci / KCH, cc = ci - kr * KCH; kreg[i_] = *(const u32x4*)(a.K + (rowb + (kp) + kr) * 256 + kvh * 128 + cc * 8); } \
        _Pragma("unroll") for (int i_ = 0; i_ < NVC; ++i_) { const int ci = tl_ + 512 * i_, kr = ci / VCH, cc = ci - kr * VCH; vreg[i_] = *(const u32x4*)(a.V + (rowb + (kp) + kr) * 256 + kvh * 128 + cc * 8); } } while (0)
        { int tl_ = tid; asm volatile("" : "+v"(tl_)); A16_LOAD(kbase0); }
        for (int j = 0; j < ntiles; ++j) {
            int tl_ = tid; asm volatile("" : "+v"(tl_));
            const int ln_ = tl_ & 63, c = ln_ & 15, g = ln_ >> 4;
            __syncthreads();
#pragma unroll
            for (int i_ = 0; i_ < NKC; ++i_) { const int ci = tl_ + 512 * i_, kr = ci / KCH, cc = ci - kr * KCH; *(LAS u32x4*)(lds + kr * KSTR + cc * 16) = kreg[i_]; }
#pragma unroll
            for (int i_ = 0; i_ < NVC; ++i_) { const int ci = tl_ + 512 * i_, kr = ci / VCH, cc = ci - kr * VCH; *(LAS u32x4*)(lds + VOFF + kr * VSTR + cc * 16) = vreg[i_]; }
            __syncthreads();
            if (j + 1 < ntiles) A16_LOAD(kbase0 + 64 * (j + 1));
            f32x4 sacc[2][4];
#pragma unroll
            for (int qb = 0; qb < 2; ++qb)
#pragma unroll
                for (int kb = 0; kb < 4; ++kb) { const float nm = -mrun[qb]; sacc[qb][kb] = (f32x4){nm, nm, nm, nm}; }
            const LAS unsigned char* kbase = lds + c * KSTR + 16 * g;
#pragma unroll
            for (int s = 0; s < 4; ++s) {
#pragma unroll
                for (int kb = 0; kb < 4; ++kb) {
                    const bf16x8 kf = *(const LAS bf16x8*)(kbase + 16 * kb * KSTR + 64 * s);
                    sacc[0][kb] = __builtin_amdgcn_mfma_f32_16x16x32_bf16(kf, qf[0][s], sacc[0][kb], 0, 0, 0);
                    sacc[1][kb] = __builtin_amdgcn_mfma_f32_16x16x32_bf16(kf, qf[1][s], sacc[1][kb], 0, 0, 0);
                }
                if (s & 1) asm volatile("" ::: "memory");
            }
            float mx[2];
#pragma unroll
            for (int qb = 0; qb < 2; ++qb) {
                float m_ = sacc[qb][0][0];
#pragma unroll
                for (int kb = 0; kb < 4; ++kb)
#pragma unroll
                    for (int jj = 0; jj < 4; ++jj) m_ = fmaxf(m_, sacc[qb][kb][jj]);
                m_ = fmaxf(m_, __shfl_xor(m_, 16)); m_ = fmaxf(m_, __shfl_xor(m_, 32));
                mx[qb] = m_;
            }
            if (!__all(fmaxf(mx[0], mx[1]) <= 8.0f)) {
#pragma unroll
                for (int qb = 0; qb < 2; ++qb) {
                    const float d = fmaxf(mx[qb], 0.f), alpha = __builtin_amdgcn_exp2f(-d);
                    mrun[qb] += d; lrun[qb] *= alpha;
#pragma unroll
                    for (int vb = 0; vb < 8; ++vb) oacc[qb][vb] *= alpha;
#pragma unroll
                    for (int kb = 0; kb < 4; ++kb) sacc[qb][kb] -= d;
                }
            }
            bf16x8 pf[2][2];
#pragma unroll
            for (int qb = 0; qb < 2; ++qb) {
                float sum = 0.f;
#pragma unroll
                for (int kb = 0; kb < 4; ++kb)
#pragma unroll
                    for (int jj = 0; jj < 4; ++jj) { const float pp = __builtin_amdgcn_exp2f(sacc[qb][kb][jj]); sacc[qb][kb][jj] = pp; sum += pp; }
                asm volatile("" : "+v"(sum));
                lrun[qb] += sum;
#pragma unroll
                for (int t = 0; t < 2; ++t) {
                    u32x4 pw; pw.x = pk2(sacc[qb][2 * t][0], sacc[qb][2 * t][1]); pw.y = pk2(sacc[qb][2 * t][2], sacc[qb][2 * t][3]);
                    pw.z = pk2(sacc[qb][2 * t + 1][0], sacc[qb][2 * t + 1][1]); pw.w = pk2(sacc[qb][2 * t + 1][2], sacc[qb][2 * t + 1][3]);
                    pf[qb][t] = __builtin_bit_cast(bf16x8, pw);
                }
            }
            {
                LAS unsigned char* vbase = lds + VOFF + (4 * g + (c >> 2)) * VSTR + 8 * (c & 3);
#pragma unroll
                for (int t = 0; t < 2; ++t) {
#pragma unroll
                    for (int vb = 0; vb < 8; ++vb) {
                        const s16x4 lo = __builtin_amdgcn_ds_read_tr16_b64_v4i16((LAS s16x4*)(vbase + (32 * t) * VSTR + 32 * vb));
                        const s16x4 hi = __builtin_amdgcn_ds_read_tr16_b64_v4i16((LAS s16x4*)(vbase + (32 * t + 16) * VSTR + 32 * vb));
                        const bf16x8 va = __builtin_shufflevector(lo, hi, 0, 1, 2, 3, 4, 5, 6, 7);
                        oacc[0][vb] = __builtin_amdgcn_mfma_f32_16x16x32_bf16(va, pf[0][t], oacc[0][vb], 0, 0, 0);
                        oacc[1][vb] = __builtin_amdgcn_mfma_f32_16x16x32_bf16(va, pf[1][t], oacc[1][vb], 0, 0, 0);
                        if (vb == 7) asm volatile("" ::: "memory");
                    }
                }
            }
        }
#undef A16_LOAD
#pragma unroll
        for (int qb = 0; qb < 2; ++qb) {
            float l_ = lrun[qb]; l_ += __shfl_xor(l_, 16); l_ += __shfl_xor(l_, 32);
            const float inv = 1.0f / l_;
            bf16_t* op = a.O + (rowb + q0 + 16 * qb + c) * 1024 + head * 128 + 4 * g;
#pragma unroll
            for (int vb = 0; vb < 8; ++vb) {
                u32x2 w2; w2.x = pk2(oacc[qb][vb][0] * inv, oacc[qb][vb][1] * inv); w2.y = pk2(oacc[qb][vb][2] * inv, oacc[qb][vb][3] * inv);
                *(u32x2*)(op + 16 * vb) = w2;
            }
        }
    }
    __syncthreads();
}

DI float* xrow_ptr(float* xlat, float* xctx, int m) { const int b = m / TPB, pos = m - b * TPB; return pos < 4096 ? xlat + ((size_t)b * 4096 + pos) * DM : xctx + ((size_t)b * 256 + (pos - 4096)) * DM; }
DI int modrow(int m) { const int b = m / TPB, pos = m - b * TPB; return pos < 4096 ? b : 4; }

struct RowPar { f32x4 G[4], B[4], GT[4], SH[4], SC[4]; };
template <bool LN> DI void rows_load(kaptr p, int b, int pos, int lane, f32x4 (&v)[4], int ctx_ks, const float* gate, const bf16_t* Y, bool x_in, const RowPar& P) {
    const float* src;
    if (!LN || x_in) src = pos < 4096 ? KIN(p, 0) + ((size_t)b * 4096 + pos) * DM : KIN(p, 2) + ((size_t)b * 256 + (pos - 4096)) * DM;
    else src = pos < 4096 ? KOUT(p) + ((size_t)b * 4096 + pos) * DM : (const float*)(KWS(p) + WS_XC) + ((size_t)b * 256 + (pos - 4096)) * DM;
    if (!LN) {
#pragma unroll
        for (int j = 0; j < 4; ++j) v[j] = *(const f32x4*)(src + 4 * lane + 256 * j);
    } else if (pos >= 4096) {
        const float* pp = (const float*)(KWS(p) + WS_PART) + ((size_t)b * 256 + (pos - 4096)) * DM + 4 * lane;
        const float* gp = gate + (size_t)4 * MODW + 4 * lane;
#pragma unroll
        for (int j = 0; j < 4; ++j) {
            f32x4 a = *(const f32x4*)(pp + 256 * j);
            for (int ks = 1; ks < ctx_ks; ++ks) a += *(const f32x4*)(pp + (size_t)ks * 1024 * DM + 256 * j);
            v[j] = *(const f32x4*)(src + 4 * lane + 256 * j) * ALPHA + *(const f32x4*)(gp + 256 * j) * a;
        }
    } else {
        const bf16_t* yp = Y + ((size_t)b * TPB + pos) * DM + 4 * lane;
#pragma unroll
        for (int j = 0; j < 4; ++j) {
            const u32x2 yw = *(const u32x2*)(yp + 256 * j);
            const f32x4 y = {bflo(yw.x), bfhi(yw.x), bflo(yw.y), bfhi(yw.y)};
            v[j] = *(const f32x4*)(src + 4 * lane + 256 * j) * ALPHA + P.GT[j] * y;
        }
    }
}
template <bool LN> DI void rows_finish(kaptr p, int b, int pos, int lane, f32x4 (&v)[4], const float* modp, bool write_h, const RowPar& P) {
    float* xr = pos < 4096 ? KOUT(p) + ((size_t)b * 4096 + pos) * DM : (float*)(KWS(p) + WS_XC) + ((size_t)b * 256 + (pos - 4096)) * DM;
    if (LN) {
        float s = 0.f;
#pragma unroll
        for (int j = 0; j < 4; ++j) s += (v[j].x + v[j].y) + (v[j].z + v[j].w);
        const float mean = wave_sum(s) * (1.0f / DM);
        float s2 = 0.f;
#pragma unroll
        for (int j = 0; j < 4; ++j) { v[j] = v[j] - mean; s2 += (v[j].x * v[j].x + v[j].y * v[j].y) + (v[j].z * v[j].z + v[j].w * v[j].w); }
        const float rstd = rsqrtf(wave_sum(s2) * (1.0f / DM) + 1e-5f);
#pragma unroll
        for (int j = 0; j < 4; ++j) v[j] = v[j] * rstd * P.G[j] + P.B[j];
#pragma unroll
        for (int j = 0; j < 4; ++j) *(f32x4*)(xr + 4 * lane + 256 * j) = v[j];
    }
    if (write_h) {
        bf16_t* H = (bf16_t*)(KWS(p) + WS_H) + ((size_t)b * TPB + pos) * DM;
        if (pos < 4096) {
#pragma unroll
            for (int j = 0; j < 4; ++j) { const f32x4 hh = v[j] * (P.SC[j] + 1.0f) + P.SH[j]; u32x2 w2; w2.x = pk2(hh.x, hh.y); w2.y = pk2(hh.z, hh.w); *(u32x2*)(H + 4 * lane + 256 * j) = w2; }
        } else {
            const float* mp = modp + (size_t)4 * MODW;
#pragma unroll
            for (int j = 0; j < 4; ++j) { const f32x4 sh = *(const f32x4*)(mp + 4 * lane + 256 * j), sc = *(const f32x4*)(mp + DM + 4 * lane + 256 * j);
                const f32x4 hh = v[j] * (sc + 1.0f) + sh; u32x2 w2; w2.x = pk2(hh.x, hh.y); w2.y = pk2(hh.z, hh.w); *(u32x2*)(H + 4 * lane + 256 * j) = w2; }
        }
    }
}
template <bool LN> DI void rows_phase(kaptr p, int wv, const float* lng, const float* lnb, const float* modp, bool write_h, int ctx_ks = 0, const float* gate = nullptr, const bf16_t* Y = nullptr, bool x_in = false) {
    const int lane = tidx(wv) & 63, gw = bidx() * 8 + (tidx(wv) >> 6), NW4 = (gridDim.x * 8) >> 2;
    const int b = gw & 3, w4 = gw >> 2;
    RowPar P;
#pragma unroll
    for (int j = 0; j < 4; ++j) {
        const f32x4 z4 = {0.f, 0.f, 0.f, 0.f};
        P.G[j] = LN ? *(const f32x4*)(lng + 4 * lane + 256 * j) : z4; P.B[j] = LN ? *(const f32x4*)(lnb + 4 * lane + 256 * j) : z4;
        P.GT[j] = LN ? *(const f32x4*)(gate + (size_t)b * MODW + 4 * lane + 256 * j) : z4;
        P.SH[j] = write_h ? *(const f32x4*)(modp + (size_t)b * MODW + 4 * lane + 256 * j) : z4; P.SC[j] = write_h ? *(const f32x4*)(modp + (size_t)b * MODW + DM + 4 * lane + 256 * j) : z4;
    }
    const int limit = ctx_ks < 0 ? SEQ : TPB;
    for (int pos = w4; pos < limit; pos += NW4) {
        f32x4 va[4];
        rows_load<LN>(p, b, pos, lane, va, ctx_ks, gate, Y, x_in, P);
        rows_finish<LN>(p, b, pos, lane, va, modp, write_h, P);
    }
}

DI void kpost_a(kaptr p, int wv, const float* kgain) {
    bf16_t* K = (bf16_t*)(KWS(p) + WS_AK); const f32x2* rope = (const f32x2*)(KWS(p) + WS_ROPEA);
    const int lane = tidx(wv) & 63, j16 = lane & 15, sub = lane >> 4, gw = bidx() * 8 + (tidx(wv) >> 6), NGW = gridDim.x * 8;
    for (int it = gw; it < MROWS * 2 / 4; it += NGW) {
        const int item = it * 4 + sub, m = item >> 1, kvh = item & 1;
        const int b = m / TPB, pos = m - b * TPB; const bool lat = pos < 4096;
        unsigned* kp = (unsigned*)(K + (size_t)m * 256 + kvh * 128) + j16;
        float v[4][2]; float ss = 0.f;
#pragma unroll
        for (int k = 0; k < 4; ++k) { const unsigned wv = kp[16 * k]; v[k][0] = bflo(wv); v[k][1] = bfhi(wv); ss += v[k][0] * v[k][0] + v[k][1] * v[k][1]; }
        ss += __shfl_xor(ss, 1); ss += __shfl_xor(ss, 2); ss += __shfl_xor(ss, 4); ss += __shfl_xor(ss, 8);
        const float rstd = rsqrtf(ss * (1.0f / 128.0f) + 1e-6f);
#pragma unroll
        for (int k = 0; k < 4; ++k) { v[k][0] *= rstd * kgain[32 * k + 2 * j16]; v[k][1] *= rstd * kgain[32 * k + 2 * j16 + 1]; }
        if (lat) {
            const int pr = pos >> 6, pc = pos & 63;
#pragma unroll
            for (int g = 0; g < 2; ++g)
#pragma unroll
                for (int e = 0; e < 2; ++e) {
                    const f32x2 cs = rope[(g ? pc : pr) * 32 + 2 * j16 + e];
                    const float t1 = v[2 * g][e], t2 = v[2 * g + 1][e];
                    v[2 * g][e] = t1 * cs.x - t2 * cs.y; v[2 * g + 1][e] = t2 * cs.x + t1 * cs.y;
                }
        }
#pragma unroll
        for (int k = 0; k < 4; ++k) kp[16 * k] = pk2(v[k][0], v[k][1]);
    }
}
DI void post_c(kaptr p, int wv, const float* qg, const float* kvg) {
    bf16_t* QL = (bf16_t*)(KWS(p) + WS_CQL); bf16_t* KVL = (bf16_t*)(KWS(p) + WS_CKVL); bf16_t* KR = (bf16_t*)(KWS(p) + WS_CKR); const f32x2* rope = (const f32x2*)(KWS(p) + WS_ROPEC);
    const int lane = tidx(wv) & 63, gw = bidx() * 8 + (tidx(wv) >> 6), NGW = gridDim.x * 8;
    for (int m = gw; m < MROWS; m += NGW) {
        const int b = m / TPB, pos = m - b * TPB;
        {   unsigned* qp = (unsigned*)(QL + (size_t)m * 384) + lane; float v[3][2]; float ss = 0.f;
#pragma unroll
            for (int k = 0; k < 3; ++k) { const unsigned wv = qp[64 * k]; v[k][0] = bflo(wv); v[k][1] = bfhi(wv); ss += v[k][0] * v[k][0] + v[k][1] * v[k][1]; }
            const float rstd = rsqrtf(wave_sum(ss) * (1.0f / 384.0f) + 1e-6f);
#pragma unroll
            for (int k = 0; k < 3; ++k) qp[64 * k] = pk2(v[k][0] * rstd * qg[128 * k + 2 * lane], v[k][1] * rstd * qg[128 * k + 2 * lane + 1]); }
        {   unsigned* kp = (unsigned*)(KVL + (size_t)m * 256) + lane; float v[2][2]; float ss = 0.f;
#pragma unroll
            for (int k = 0; k < 2; ++k) { const unsigned wv = kp[64 * k]; v[k][0] = bflo(wv); v[k][1] = bfhi(wv); ss += v[k][0] * v[k][0] + v[k][1] * v[k][1]; }
            const float rstd = rsqrtf(wave_sum(ss) * (1.0f / 256.0f) + 1e-6f);
#pragma unroll
            for (int k = 0; k < 2; ++k) kp[64 * k] = pk2(v[k][0] * rstd * kvg[128 * k + 2 * lane], v[k][1] * rstd * kvg[128 * k + 2 * lane + 1]); }
        if (pos < 4096 && lane < 32) {
            const int g = lane >> 4, i = lane & 15; bf16_t* kr = KR + (size_t)m * 64 + 32 * g + i;
            const f32x2 cs = rope[(g ? (pos & 63) : (pos >> 6)) * 16 + i];
            const float t1 = bflo((unsigned)kr[0]), t2 = bflo((unsigned)kr[16]);
            kr[0] = (bf16_t)(pk2(t1 * cs.x - t2 * cs.y, 0.f) & 0xffffu); kr[16] = (bf16_t)(pk2(t2 * cs.x + t1 * cs.y, 0.f) & 0xffffu);
        }
    }
}

struct WJob { int in_idx, src_off, K, N, kind, pad; size_t dst; };
#define WJ_FFN(l) {8, (l) * DM * DFF, DM, DFF, 1, 0, WS_WGU(l)}, {9, (l) * DM * DFF, DM, DFF, 2, 0, WS_WGU(l)}, {10, (l) * DFF * DM, DFF, DM, 0, 0, WS_WD(l)}
__constant__ WJob kJobs[22] = {
    WJ_FFN(0), WJ_FFN(1), WJ_FFN(2), WJ_FFN(3),
    {11, 0, DM, 1536, 0, 0, WS_WA_QKV(0)}, {14, 0, DM, DM, 0, 0, WS_WA_O(0)}, {11, DM * 1536, DM, 1536, 0, 0, WS_WA_QKV(1)}, {14, DM * DM, DM, DM, 0, 0, WS_WA_O(1)},
    {15, 0, DM, 3072, 0, 0, WS_WB_QKV}, {17, 0, DM, DM, 0, 0, WS_WB_O},
    {18, 0, DM, 704, 0, 0, WS_WC_DQKV}, {21, 0, 384, 1536, 0, 0, WS_WC_UQ}, {22, 0, 256, 2048, 0, 0, WS_WC_UKV}, {23, 0, DM, DM, 0, 0, WS_WC_O}};
constexpr int NMOD_ITEMS = DEPTH * (MODW / 64);

DI void prologue_a(kaptr p, LAS unsigned char* lds, int wv) {
    const int tid = tidx(wv), lane = tid & 63, w = tid >> 6;
    LAS float* cond = (LAS float*)(lds);
    LAS float* red = (LAS float*)(lds + 20480);
    if (bidx() < NMOD_ITEMS) {
        for (int t = tid; t < 5 * DM; t += 512) { const float cv = t < 4 * DM ? KIN(p, 1)[t] : KIN(p, 3)[t - 4 * DM]; cond[t] = cv / (1.0f + __expf(-cv)); }
    }
    for (int it = bidx(); it < NMOD_ITEMS; it += gridDim.x) {
        __syncthreads();
        const int layer = it / (MODW / 64), n0 = (it - layer * (MODW / 64)) * 64;
        const float* wp = KIN(p, 4) + (size_t)layer * DM * MODW + (size_t)(128 * w) * MODW + n0 + lane;
        float acc[5] = {0.f, 0.f, 0.f, 0.f, 0.f};
#pragma unroll 16
        for (int k = 0; k < 128; ++k) { const float wv1 = wp[(size_t)k * MODW];
#pragma unroll
            for (int rI = 0; rI < 5; ++rI) acc[rI] += cond[rI * DM + 128 * w + k] * wv1; }
#pragma unroll
        for (int rI = 0; rI < 5; ++rI) red[(w * 5 + rI) * 64 + lane] = acc[rI];
        __syncthreads();
        if (tid < 320) { const int rI = tid >> 6; float sm = KIN(p, 5)[(size_t)layer * MODW + n0 + lane];
#pragma unroll
            for (int ww = 0; ww < 8; ++ww) sm += red[(ww * 5 + rI) * 64 + lane];
            ((float*)(KWS(p) + WS_MOD))[((size_t)layer * 5 + rI) * MODW + n0 + lane] = sm; }
    }
    {
        int nitem_total = 0;
        for (int j = 0; j < 22; ++j) nitem_total += (kJobs[j].K / 64) * (kJobs[j].N / 32);
        LAS float* scr = (LAS float*)(lds + 65536 + w * 8448);
        const int kr = lane >> 3, c4 = lane & 7, nrow = lane >> 1, hf = lane & 1;
        for (int it = bidx() * 8 + w; it < nitem_total; it += gridDim.x * 8) {
            int t = it, j = 0;
            for (; j < 21; ++j) { const int nt = (kJobs[j].K / 64) * (kJobs[j].N / 32); if (t < nt) break; t -= nt; }
            const WJob jb = kJobs[j];
            const int nblk = jb.N / 32, kb = t / nblk, nb = t - kb * nblk, k0 = 64 * kb, n0 = 32 * nb;
            const float* W = KIN(p, jb.in_idx) + jb.src_off + (size_t)(k0 + kr) * jb.N + n0 + 4 * c4;
            f32x4 v4[8];
#pragma unroll
            for (int i = 0; i < 8; ++i) v4[i] = *(const f32x4*)(W + (size_t)(8 * i) * jb.N);
#pragma unroll
            for (int i = 0; i < 8; ++i) { const int kk = 8 * i + kr; scr[(4 * c4 + 0) * 65 + kk] = v4[i].x; scr[(4 * c4 + 1) * 65 + kk] = v4[i].y; scr[(4 * c4 + 2) * 65 + kk] = v4[i].z; scr[(4 * c4 + 3) * 65 + kk] = v4[i].w; }
            asm volatile("s_waitcnt lgkmcnt(0)" ::: "memory");
            const int nn = n0 + nrow; const int drow = jb.kind == 0 ? nn : 256 * (nn >> 7) + (nn & 127) + (jb.kind == 2 ? 128 : 0);
            bf16_t* dp = (bf16_t*)(KWS(p) + jb.dst) + (size_t)drow * jb.K + k0 + 32 * hf;
#pragma unroll
            for (int q = 0; q < 4; ++q) {
                const LAS float* sp = scr + nrow * 65 + 32 * hf + 8 * q;
                u32x4 o; o.x = pk2(sp[0], sp[1]); o.y = pk2(sp[2], sp[3]); o.z = pk2(sp[4], sp[5]); o.w = pk2(sp[6], sp[7]);
                *(u32x4*)(dp + 8 * q) = o;
            }
            asm volatile("s_waitcnt lgkmcnt(0)" ::: "memory");
        }
    }
    const int gt = bidx() * 512 + tid, NGT = gridDim.x * 512;
    for (int t = gt; t < 64 * 32; t += NGT) { const int pos = t >> 5, i = t & 31; const float f = exp2f(-(float)(2 * i) * (1.0f / 64.0f) * 13.287712379549449f); float sn, cs; sincosf((float)pos * f, &sn, &cs); ((f32x2*)(KWS(p) + WS_ROPEA))[t] = (f32x2){cs, sn}; }
    for (int t = gt; t < 64 * 16; t += NGT) { const int pos = t >> 4, i = t & 15; const float f = exp2f(-(float)(2 * i) * (1.0f / 32.0f) * 13.287712379549449f); float sn, cs; sincosf((float)pos * f, &sn, &cs); ((f32x2*)(KWS(p) + WS_ROPEC))[t] = (f32x2){cs, sn}; }
    for (int t = gt; t < 64 * DM / 8; t += NGT) ((u32x4*)((bf16_t*)(KWS(p) + WS_WC_DQKV) + (size_t)704 * DM))[t] = (u32x4){0u, 0u, 0u, 0u};
    __syncthreads();
}

constexpr int NPHASES = 2 + 9 * DEPTH;
#if defined(PROBE_MASK)
#ifndef PROBE_LAYER
#define PROBE_LAYER -1
#endif
#define PROBE_SEL(k) ((k) < 2 ? ((PROBE_MASK >> (9 + (k))) & 1) : (((PROBE_MASK >> (((k) - 2) % 9)) & 1) && (PROBE_LAYER < 0 || ((k) - 2) / 9 == PROBE_LAYER)))
#define TSTART(k) if (PROBE_SEL(k)) tq0 = __builtin_amdgcn_s_memrealtime();
#define TSTOP(k) if (PROBE_SEL(k)) tacc += __builtin_amdgcn_s_memrealtime() - tq0;
#else
#define TSTART(k)
#define TSTOP(k)
#endif
#define PHASE_BEGIN(k) if (lo <= (k) && (k) < hi) { TSTART(k) kaptr p = (kaptr)__builtin_amdgcn_kernarg_segment_ptr(); asm volatile("" : "+s"(p)); unsigned char* ws = KWS(p); (void)ws;
#if defined(PROBE_SEAM2)
#define PHASE_END(k) if ((k) + 1 < hi) { gbar((unsigned*)(KWS(p) + WS_BAR), (LAS unsigned*)(lds + LDS_BYTES - 64), wv); gbar((unsigned*)(KWS(p) + WS_BAR), (LAS unsigned*)(lds + LDS_BYTES - 64), wv); } TSTOP(k) }
#else
#define PHASE_END(k) if ((k) + 1 < hi) gbar((unsigned*)(KWS(p) + WS_BAR), (LAS unsigned*)(lds + LDS_BYTES - 64), wv); TSTOP(k) }
#endif
#define XB_XCNT(j)  (256  + 64 * (j))
#define XB_XSUB(j)  (1280 + 64 * (j))
#define XB_XGEN(j)  (2304 + 64 * (j))
#define XB_TOP      3328
#define XB_TOPGEN   3392
#define XCD_BAR_WORDS 3456
DI unsigned xb_ld(unsigned* p_) { return __hip_atomic_load(p_, __ATOMIC_RELAXED, __HIP_MEMORY_SCOPE_AGENT); }
DI unsigned xb_add(unsigned* p_, unsigned v) { return __hip_atomic_fetch_add(p_, v, __ATOMIC_RELAXED, __HIP_MEMORY_SCOPE_AGENT); }
DI unsigned xb_xcc_id() { return (unsigned)__builtin_amdgcn_s_getreg((3 << 11) | 20) & 0xFu; }
DI void gbar(unsigned* bar, LAS unsigned* st, int wv) {
    asm volatile("s_waitcnt vmcnt(0)" ::: "memory");
    __syncthreads();
    if (tidx(wv) == 0) {
        __builtin_amdgcn_s_waitcnt(0);
        const unsigned x = xb_xcc_id();
        unsigned nloc = st[0], nx = st[1];
        if (nloc == 0u) {
            const unsigned G = gridDim.x;
            for (;;) { unsigned sum = 0u, cnt = 0u, mine = 0u;
#pragma unroll
                for (unsigned j = 0; j < 16; ++j) { const unsigned c = xb_ld(&bar[XB_XCNT(j)]); sum += c; cnt += (c > 0u) ? 1u : 0u; mine = (j == x) ? c : mine; }
                if (sum == G) { nloc = mine; nx = cnt; break; }
                __builtin_amdgcn_s_sleep(1); }
            st[0] = nloc; st[1] = nx;
        }
        const unsigned old = xb_add(&bar[XB_XSUB(x)], 1u);
        const unsigned gen = old / nloc;
        if (old + 1u == (gen + 1u) * nloc) {
            __builtin_amdgcn_fence(__ATOMIC_RELEASE, "agent");
            asm volatile("s_waitcnt vmcnt(0)" ::: "memory");
            const unsigned og = xb_add(&bar[XB_TOP], 1u);
            const unsigned tg = og / nx;
            if (og + 1u == (tg + 1u) * nx) xb_add(&bar[XB_TOPGEN], 1u);
            else while (xb_ld(&bar[XB_TOPGEN]) == tg) __builtin_amdgcn_s_sleep(1);
            __builtin_amdgcn_fence(__ATOMIC_ACQUIRE, "agent");
            xb_add(&bar[XB_XGEN(x)], 1u);
            asm volatile("s_waitcnt vmcnt(0)" ::: "memory");
        } else {
            while (xb_ld(&bar[XB_XGEN(x)]) == gen) __builtin_amdgcn_s_sleep(1);
            __builtin_amdgcn_fence(__ATOMIC_ACQUIRE, "agent");
            asm volatile("s_waitcnt vmcnt(0)" ::: "memory");
        }
    }
    __syncthreads();
}
template <int LAYER> DI void layer_phases(int lo, int hi, LAS unsigned char* lds, int wv, unsigned& nbar, unsigned long long& tacc) {
    unsigned long long tq0 = 0; (void)tq0;
    constexpr int kind = LAYER % 3, inst = LAYER / 3, P0 = 2 + 9 * LAYER; constexpr bool LASTL = LAYER == DEPTH - 1;
    constexpr size_t MODL = WS_MOD + (size_t)LAYER * 5 * MODW * 4;
    PHASE_BEGIN(P0 + 0)
        bf16_t* H = (bf16_t*)(ws + WS_H);
        if constexpr (kind == 0) { const EpiStore E = EpiStore::make((bf16_t*)(ws + WS_AQ), (bf16_t*)(ws + WS_AK), (bf16_t*)(ws + WS_AV), 1024, 1280, 1024, 256, 256, 1536);
            run_gemm(lds, wv, H, (const bf16_t*)(ws + WS_WA_QKV(inst)), MROWS, 1536, DM, E); }
        else if constexpr (kind == 1) { const EpiStore E = EpiStore::make((bf16_t*)(ws + WS_BQ), (bf16_t*)(ws + WS_BK), (bf16_t*)(ws + WS_BV), 1024, 2048, 1024, 1024, 1024, 3072);
            run_gemm(lds, wv, H, (const bf16_t*)(ws + WS_WB_QKV), MROWS, 3072, DM, E); }
        else { const EpiStore E = EpiStore::make((bf16_t*)(ws + WS_CQL), (bf16_t*)(ws + WS_CKVL), (bf16_t*)(ws + WS_CKR), 384, 640, 384, 256, 64, 704);
            run_gemm(lds, wv, H, (const bf16_t*)(ws + WS_WC_DQKV), MROWS, 768, DM, E); }
    PHASE_END(P0 + 0)
    if constexpr (kind == 0) { PHASE_BEGIN(P0 + 1) kpost_a(p, wv, KIN(p, 13) + inst * 128); PHASE_END(P0 + 1) }
    if constexpr (kind == 2) {
        PHASE_BEGIN(P0 + 1) post_c(p, wv, KIN(p, 19), KIN(p, 20)); PHASE_END(P0 + 1)
        PHASE_BEGIN(P0 + 2)
            { const EpiStore E = EpiStore::make((bf16_t*)(ws + WS_CQ), (bf16_t*)(ws + WS_CQ), (bf16_t*)(ws + WS_CQ), 0, 0, 1536, 1536, 1536, 1536);
              run_gemm(lds, wv, (const bf16_t*)(ws + WS_CQL), (const bf16_t*)(ws + WS_WC_UQ), MROWS, 1536, 384, E); }
            { const EpiStore E = EpiStore::make((bf16_t*)(ws + WS_CKV), (bf16_t*)(ws + WS_CKV), (bf16_t*)(ws + WS_CKV), 0, 0, 2048, 2048, 2048, 2048);
              run_gemm(lds, wv, (const bf16_t*)(ws + WS_CKVL), (const bf16_t*)(ws + WS_WC_UKV), MROWS, 2048, 256, E); }
        PHASE_END(P0 + 2)
    }
    PHASE_BEGIN(P0 + 3)
        bf16_t* H = (bf16_t*)(ws + WS_H);
#if defined(PROBE_ATT2)
        for (int rep_ = 0; rep_ < 2; ++rep_) { if (rep_) gbar((unsigned*)(ws + WS_BAR), (LAS unsigned*)(lds + LDS_BYTES - 64), wv);
#endif
        if constexpr (kind == 0) { const AttnArgs a{(const bf16_t*)(ws + WS_AQ), (const bf16_t*)(ws + WS_AK), (const bf16_t*)(ws + WS_AV), nullptr, H, KIN(p, 12) + inst * 128, nullptr, (const f32x2*)(ws + WS_ROPEA)}; attn_phase16(lds, a, wv, LAYER != DEPTH - 1); }
        else if constexpr (kind == 1) { const AttnArgs a{(const bf16_t*)(ws + WS_BQ), (const bf16_t*)(ws + WS_BK), (const bf16_t*)(ws + WS_BV), nullptr, H, nullptr, KIN(p, 16), nullptr}; attn_phase<1>(lds, a, wv, LAYER != DEPTH - 1); }
        else { const AttnArgs a{(const bf16_t*)(ws + WS_CQ), (const bf16_t*)(ws + WS_CKV), (const bf16_t*)(ws + WS_CKV), (const bf16_t*)(ws + WS_CKR), H, nullptr, nullptr, (const f32x2*)(ws + WS_ROPEC)}; attn_phase<2>(lds, a, wv, LAYER != DEPTH - 1); }
#if defined(PROBE_ATT2)
        }
#endif
    PHASE_END(P0 + 3)
    PHASE_BEGIN(P0 + 4)
        constexpr size_t WO = kind == 0 ? WS_WA_O(inst) : (kind == 1 ? WS_WB_O : WS_WC_O);
        const EpiResid E{(bf16_t*)(ws + WS_R), (float*)(ws + WS_PART)};
        run_gemm_lat(lds, wv, (const bf16_t*)(ws + WS_H), (const bf16_t*)(ws + WO), DM, DM, LASTL ? 0 : 4, E);
    PHASE_END(P0 + 4)
    PHASE_BEGIN(P0 + 5) rows_phase<true>(p, wv, KIN(p, 6) + (size_t)(LAYER * 2 + 0) * DM, KIN(p, 7) + (size_t)(LAYER * 2 + 0) * DM, (const float*)(ws + MODL) + 3 * DM, true, LASTL ? -1 : 4, (const float*)(ws + MODL) + 2 * DM, (const bf16_t*)(ws + WS_R), LAYER == 0); PHASE_END(P0 + 5)
    PHASE_BEGIN(P0 + 6) const EpiSwiGLU E{(bf16_t*)(ws + WS_ACT)};
#if defined(PROBE_UP2)
        run_gemm(lds, wv, (const bf16_t*)(ws + WS_H), (const bf16_t*)(ws + WS_WGU(LAYER)), MROWS, 2 * DFF, DM, E); gbar((unsigned*)(ws + WS_BAR), (LAS unsigned*)(lds + LDS_BYTES - 64), wv);
#endif
        if constexpr (LASTL) run_gemm_lat(lds, wv, (const bf16_t*)(ws + WS_H), (const bf16_t*)(ws + WS_WGU(LAYER)), 2 * DFF, DM, 0, E);
        else run_gemm(lds, wv, (const bf16_t*)(ws + WS_H), (const bf16_t*)(ws + WS_WGU(LAYER)), MROWS, 2 * DFF, DM, E);
    PHASE_END(P0 + 6)
    PHASE_BEGIN(P0 + 7) const EpiResid E{(bf16_t*)(ws + WS_H), (float*)(ws + WS_PART)};     run_gemm_lat(lds, wv, (const bf16_t*)(ws + WS_ACT), (const bf16_t*)(ws + WS_WD(LAYER)), DM, DFF, LASTL ? 0 : 11, E); PHASE_END(P0 + 7)
    PHASE_BEGIN(P0 + 8) constexpr bool last = LAYER == DEPTH - 1;
        rows_phase<true>(p, wv, KIN(p, 6) + (size_t)(LAYER * 2 + 1) * DM, KIN(p, 7) + (size_t)(LAYER * 2 + 1) * DM, (const float*)(ws + MODL) + (last ? 0 : 5 * MODW), !last, LASTL ? -1 : 11, (const float*)(ws + MODL) + 5 * DM, (const bf16_t*)(ws + WS_H)); PHASE_END(P0 + 8)
}
static bool phase_exists(int ph) {
    if (ph < 2) return true;
    const int layer = (ph - 2) / 9, step = (ph - 2) - layer * 9, kind = layer % 3;
    if (step == 1) return kind != 1;
    if (step == 2) return kind == 2;
    return true;
}

__global__ void __launch_bounds__(512, 2) mk_fwd(Params prm) {
    extern __shared__ __attribute__((aligned(16))) unsigned char lds_raw[];
    LAS unsigned char* lds = (LAS unsigned char*)lds_raw;
    const int wv = __builtin_amdgcn_readfirstlane((int)(threadIdx.x >> 6));
    const int lo = prm.ph_lo, hi = prm.ph_hi;
    unsigned nbar = 0; (void)nbar;
    if (threadIdx.x < 16) ((LAS unsigned*)(lds + LDS_BYTES - 64))[threadIdx.x] = 0u;
    if (threadIdx.x == 0 && hi - lo > 1) xb_add((unsigned*)(prm.ws + WS_BAR) + XB_XCNT(xb_xcc_id()), 1u);
    __syncthreads();
    unsigned long long tacc = 0, tq0 = 0; (void)tq0;
    if (lo <= 0 && 0 < hi) { TSTART(0) kaptr p = (kaptr)__builtin_amdgcn_kernarg_segment_ptr(); asm volatile("" : "+s"(p)); prologue_a(p, lds, wv);
        if (1 < hi) cg::this_grid().sync(); TSTOP(0) }
    PHASE_BEGIN(1) rows_phase<false>(p, wv, nullptr, nullptr, (const float*)(ws + WS_MOD), true); PHASE_END(1)
    layer_phases<0>(lo, hi, lds, wv, nbar, tacc);
    layer_phases<1>(lo, hi, lds, wv, nbar, tacc);
    layer_phases<2>(lo, hi, lds, wv, nbar, tacc);
    layer_phases<3>(lo, hi, lds, wv, nbar, tacc);
#if defined(PROBE_MASK)
    { const unsigned long long t1 = __builtin_amdgcn_s_memrealtime(); while (__builtin_amdgcn_s_memrealtime() - t1 < 4ull * tacc) __builtin_amdgcn_s_sleep(8); }
#endif
}

#ifndef MK_MULTI
#define MK_MULTI 0
#endif
extern "C" void kernel_launch(void* const* d_in, const int* in_sizes, int n_in, void* d_out, int out_size, void* d_ws, size_t ws_size, hipStream_t stream) {
    static int grid = 0;
    if (grid == 0) {
        if (n_in != 24 || out_size != NBATCH * SEQ * DM || ws_size < WS_END) { fprintf(stderr, "kernel_launch: unexpected shapes (n_in %d, out %d, ws %zu < %zu)\n", n_in, out_size, ws_size, (size_t)WS_END); grid = -1; return; }
        int dev = 0, cus = 0, per_cu = 0;
        hipGetDevice(&dev); hipDeviceGetAttribute(&cus, hipDeviceAttributeMultiprocessorCount, dev);
        if (hipFuncSetAttribute((const void*)mk_fwd, hipFuncAttributeMaxDynamicSharedMemorySize, LDS_BYTES) != hipSuccess) { fprintf(stderr, "kernel_launch: hipFuncSetAttribute failed\n"); grid = -1; return; }
        if (hipOccupancyMaxActiveBlocksPerMultiprocessor(&per_cu, (const void*)mk_fwd, 512, LDS_BYTES) != hipSuccess || per_cu < 1) { fprintf(stderr, "kernel_launch: occupancy query says %d\n", per_cu); per_cu = 1; }
        (void)hipGetLastError();
        grid = cus * per_cu;
    }
    if (grid < 0) return;
    Params p{};
    for (int i = 0; i < 24; ++i) p.in[i] = (const float*)d_in[i];
    p.out = (float*)d_out; p.ws = (unsigned char*)d_ws;
#if MK_MULTI
    for (int ph = 0; ph < NPHASES; ++ph) {
        if (!phase_exists(ph)) continue;
        p.ph_lo = ph; p.ph_hi = ph + 1;
        hipLaunchKernelGGL(mk_fwd, dim3(grid), dim3(512), LDS_BYTES, stream, p);
    }
#else
    p.ph_lo = 0; p.ph_hi = NPHASES;
    if (hipMemsetAsync((char*)d_ws + WS_BAR, 0, XCD_BAR_WORDS * 4, stream) != hipSuccess) { fprintf(stderr, "kernel_launch: memset of the barrier words failed\n"); return; }
    void* args[] = {&p};
    hipError_t e = hipLaunchCooperativeKernel((const void*)mk_fwd, dim3(grid), dim3(512), args, LDS_BYTES, stream);
    if (e != hipSuccess) fprintf(stderr, "cooperative launch failed: %s (grid %d)\n", hipGetErrorString(e), grid);
#endif
}
```
